# Optimizing an MI355X kernel written in HIP

```python
import math
import jax, jax.numpy as jnp
from jax import lax
import numpy as np

D_MODEL = 2048
BATCH = 4
SEQ = 2048
DEPTH = 2
DEC_BATCH = 128
DEC_SEQ = 1
PAST_LEN = 16384
PAGE_SIZE = 128

N_EVEN = (DEPTH + 1) // 2
N_ODD = DEPTH // 2
MIX_HALF = D_MODEL // 2
RET_HEADS = 4
RET_DK = MIX_HALF // RET_HEADS
RET_CHUNK = 128
HG_HEADS = 8
HG_DK = MIX_HALF // HG_HEADS
HG_DV = MIX_HALF // HG_HEADS
HG_CHUNK = 64
S5_GROUP = 16
S5_GROUPS = D_MODEL // S5_GROUP
S5_STATE = 64
D_FF = -(-8 * D_MODEL // (3 * 256)) * 256
ROPE_BASE = 10000.0
EPS = 1e-6

kernel_name = "retention_hgrn2_s5_hybrid_step"


def _rmsnorm(x, g):
    xf = x.astype(jnp.float32)
    y = xf * lax.rsqrt(jnp.mean(xf * xf, axis=-1, keepdims=True) + EPS)
    return (y * g.astype(jnp.float32)).astype(x.dtype)


def _rotary(x, pos):
    half = x.shape[-1] // 2
    inv = ROPE_BASE ** (-jnp.arange(half, dtype=jnp.float32) / half)
    ang = pos[:, None] * inv[None, :]
    cos = jnp.cos(ang)[None, :, None, :]
    sin = jnp.sin(ang)[None, :, None, :]
    x1, x2 = x[..., :half], x[..., half:]
    return jnp.concatenate([x1 * cos - x2 * sin, x1 * sin + x2 * cos], axis=-1)


def _to_chunks(t, c):
    b, l = t.shape[:2]
    return jnp.moveaxis(t.reshape((b, l // c, c) + t.shape[2:]), 1, 0)


def _from_chunks(t):
    n, b, c = t.shape[:3]
    return jnp.moveaxis(t, 0, 1).reshape((b, n * c) + t.shape[3:])


def _retention(q, k, v, s0):
    L = q.shape[1]
    c = math.gcd(L, RET_CHUNK)
    lg = jnp.log(1.0 - 2.0 ** (-5.0 - jnp.arange(RET_HEADS, dtype=jnp.float32)))
    idx = jnp.arange(c, dtype=jnp.float32)
    causal = idx[:, None] >= idx[None, :]
    intra = jnp.exp(jnp.where(causal[None], (idx[:, None] - idx[None, :])[None] * lg[:, None, None], -jnp.inf))
    q_dec = jnp.exp((idx[:, None] + 1.0) * lg[None, :])
    k_dec = jnp.exp((c - 1.0 - idx[:, None]) * lg[None, :])
    c_dec = jnp.exp(c * lg)

    def step(s, inp):
        qc, kc, vc = inp
        att = jnp.einsum('bihd,bjhd->bhij', qc, kc) * intra[None]
        o = (jnp.einsum('bhij,bjhv->bihv', att, vc)
             + jnp.einsum('bihd,bhdv->bihv', qc * q_dec[None, :, :, None], s))
        s = s * c_dec[None, :, None, None] + jnp.einsum('bjhd,bjhv->bhdv', kc * k_dec[None, :, :, None], vc)
        return s, o

    s, o = lax.scan(step, s0, (_to_chunks(q, c), _to_chunks(k, c), _to_chunks(v, c)))
    return _from_chunks(o), s


def _hgrn2(q, k, v, log_f, s0):
    L = q.shape[1]
    c = math.gcd(L, HG_CHUNK)
    idx = jnp.arange(c)
    causal = (idx[:, None] >= idx[None, :])[None, :, :, None, None]

    def step(s, inp):
        qc, kc, vc, gc = inp
        b = jnp.cumsum(gc, axis=1)
        o_cross = jnp.einsum('bihd,bhdv->bihv', qc * jnp.exp(b), s)
        rel = jnp.exp(jnp.where(causal, b[:, :, None] - b[:, None, :], -jnp.inf))
        att = jnp.einsum('bihd,bjhd,bijhd->bhij', qc, kc, rel)
        o = o_cross + jnp.einsum('bhij,bjhv->bihv', att, vc)
        b_last = b[:, -1]
        s = s * jnp.exp(b_last)[..., None] + jnp.einsum('bjhd,bjhv->bhdv', kc * jnp.exp(b_last[:, None] - b), vc)
        return s, o

    s, o = lax.scan(step, s0, (_to_chunks(q, c), _to_chunks(k, c), _to_chunks(v, c), _to_chunks(log_f, c)))
    return _from_chunks(o), s


def _complex_affine_combine(e1, e2):
    a1r, a1i, b1r, b1i = e1
    a2r, a2i, b2r, b2i = e2
    return (a1r * a2r - a1i * a2i,
            a1r * a2i + a1i * a2r,
            a2r * b1r - a2i * b1i + b2r,
            a2r * b1i + a2i * b1r + b2i)


def _s5(u, h0_re, h0_im, lam_re, lam_im, log_dt, b_re, b_im, c_re, c_im, d_skip):
    B, L, _ = u.shape
    ug = u.astype(jnp.float32).reshape(B, L, S5_GROUPS, S5_GROUP)
    lr = lam_re.astype(jnp.float32)
    li = lam_im.astype(jnp.float32)
    dt = jnp.exp(log_dt.astype(jnp.float32))[:, None]
    mag = jnp.exp(lr * dt)
    ar = mag * jnp.cos(li * dt)
    ai = mag * jnp.sin(li * dt)
    den = lr * lr + li * li
    cr = ((ar - 1.0) * lr + ai * li) / den
    ci = (ai * lr - (ar - 1.0) * li) / den
    br = b_re.astype(jnp.float32)
    bi = b_im.astype(jnp.float32)
    bbr = cr[..., None] * br - ci[..., None] * bi
    bbi = cr[..., None] * bi + ci[..., None] * br
    bu_r = jnp.einsum('blgc,gpc->blgp', ug, bbr)
    bu_i = jnp.einsum('blgc,gpc->blgp', ug, bbi)
    h0r = h0_re.astype(jnp.float32)
    h0i = h0_im.astype(jnp.float32)
    bu_r = bu_r.at[:, 0].add(ar * h0r - ai * h0i)
    bu_i = bu_i.at[:, 0].add(ar * h0i + ai * h0r)
    a_r = jnp.broadcast_to(ar, bu_r.shape)
    a_i = jnp.broadcast_to(ai, bu_i.shape)
    _, _, hr, hi = lax.associative_scan(_complex_affine_combine, (a_r, a_i, bu_r, bu_i), axis=1)
    y = (jnp.einsum('gcp,blgp->blgc', c_re.astype(jnp.float32), hr)
         - jnp.einsum('gcp,blgp->blgc', c_im.astype(jnp.float32), hi)
         + d_skip.astype(jnp.float32).reshape(S5_GROUPS, S5_GROUP) * ug)
    return y.reshape(B, L, D_MODEL), hr[:, -1], hi[:, -1]


def _even_mixer(h, pos, s_ret, s_hg, w_in, ret_gn_g, lb, hg_gn_g, w_out):
    B, L, _ = h.shape
    proj = (h @ w_in).astype(jnp.float32)
    r_q, r_k, r_v, r_g, g_q, g_f, g_i, g_g = jnp.split(proj, 8, axis=-1)
    q = _rotary(r_q.reshape(B, L, RET_HEADS, RET_DK), pos)
    k = _rotary(r_k.reshape(B, L, RET_HEADS, RET_DK), pos) * (RET_DK ** -0.5)
    o_r, s_ret_new = _retention(q, k, r_v.reshape(B, L, RET_HEADS, RET_DK), s_ret.astype(jnp.float32))
    mu = jnp.mean(o_r, axis=-1, keepdims=True)
    var = jnp.mean(jnp.square(o_r - mu), axis=-1, keepdims=True)
    o_r = ((o_r - mu) * lax.rsqrt(var + EPS)).reshape(B, L, MIX_HALF) * ret_gn_g.astype(jnp.float32) * jax.nn.silu(r_g)
    lbf = lb.astype(jnp.float32)
    f = lbf + (1.0 - lbf) * jax.nn.sigmoid(g_f)
    hd = lambda t: t.reshape(B, L, HG_HEADS, HG_DK)
    o_h, s_hg_new = _hgrn2(hd(jax.nn.silu(g_q)), hd(1.0 - f), g_i.reshape(B, L, HG_HEADS, HG_DV),
                           hd(jnp.log(f)), s_hg.astype(jnp.float32))
    o_h = o_h * lax.rsqrt(jnp.mean(o_h * o_h, axis=-1, keepdims=True) + EPS)
    o_h = o_h.reshape(B, L, MIX_HALF) * hg_gn_g.astype(jnp.float32) * jax.nn.silu(g_g)
    mix = jnp.concatenate([o_r, o_h], axis=-1).astype(h.dtype) @ w_out
    return mix, s_ret_new, s_hg_new


def _odd_mixer(h, s_re, s_im, lam_re, lam_im, log_dt, b_re, b_im, c_re, c_im, d_skip, w_a, w_b):
    y, hr, hi = _s5(h, s_re, s_im, lam_re, lam_im, log_dt, b_re, b_im, c_re, c_im, d_skip)
    z = jax.nn.gelu(y).astype(h.dtype)
    mix = (z @ w_a) * jax.nn.sigmoid(z @ w_b)
    return mix, hr, hi


def _swiglu(h, wg, wu, wd):
    return (jax.nn.silu(h @ wg) * (h @ wu)) @ wd


def _trunk(x, pos0, s_ret, s_hg, s5_re, s5_im, weights):
    (attn_norm_g, w_in, ret_gn_g, hg_lb, hg_gn_g, w_out, ssm_norm_g, s5_lam_re, s5_lam_im,
     s5_log_dt, s5_b_re, s5_b_im, s5_c_re, s5_c_im, s5_d, w_glu_a, w_glu_b, ffn_norm_g,
     w_ffn_gate, w_ffn_up, w_ffn_down, final_norm_g) = weights
    L = x.shape[1]
    pos = pos0 + jnp.arange(L, dtype=jnp.float32)
    lb_all = jnp.cumsum(jax.nn.softmax(hg_lb.astype(jnp.float32), axis=0), axis=0)
    new_ret, new_hg, new_re, new_im = [], [], [], []
    for layer in range(DEPTH):
        j = layer // 2
        if layer % 2 == 0:
            h = _rmsnorm(x, attn_norm_g[j])
            mix, sr, sh = _even_mixer(h, pos, s_ret[j], s_hg[j], w_in[j], ret_gn_g[j], lb_all[layer],
                                      hg_gn_g[j], w_out[j])
            new_ret.append(sr.astype(s_ret.dtype))
            new_hg.append(sh.astype(s_hg.dtype))
        else:
            h = _rmsnorm(x, ssm_norm_g[j])
            mix, hr, hi = _odd_mixer(h, s5_re[j], s5_im[j], s5_lam_re[j], s5_lam_im[j], s5_log_dt[j],
                                     s5_b_re[j], s5_b_im[j], s5_c_re[j], s5_c_im[j], s5_d[j],
                                     w_glu_a[j], w_glu_b[j])
            new_re.append(hr.astype(s5_re.dtype))
            new_im.append(hi.astype(s5_im.dtype))
        x = x + mix.astype(x.dtype)
        x = x + _swiglu(_rmsnorm(x, ffn_norm_g[layer]), w_ffn_gate[layer], w_ffn_up[layer],
                        w_ffn_down[layer]).astype(x.dtype)
    y = _rmsnorm(x, final_norm_g)
    return y, jnp.stack(new_ret), jnp.stack(new_hg), jnp.stack(new_re), jnp.stack(new_im)


def setup_inputs(seed: int = 0) -> dict:
    key = jax.random.key(seed)
    ks = jax.random.split(key, 32)
    f32 = jnp.float32
    nrm = lambda k, shape, scale: scale * jax.random.normal(k, shape, f32)
    gain = lambda k, shape: 1.0 + 0.05 * jax.random.normal(k, shape, f32)
    n_idx = jnp.arange(S5_STATE, dtype=f32)
    return {
        "x_prompt": nrm(ks[0], (BATCH, SEQ, D_MODEL), 1.0),
        "x_sample": nrm(ks[1], (DEC_BATCH, DEC_SEQ, D_MODEL), 1.0),
        "state_ret": nrm(ks[2], (N_EVEN, DEC_BATCH, RET_HEADS, RET_DK, RET_DK), 0.1),
        "state_hgrn": nrm(ks[3], (N_EVEN, DEC_BATCH, HG_HEADS, HG_DK, HG_DV), 0.3),
        "state_s5_re": nrm(ks[4], (N_ODD, DEC_BATCH, S5_GROUPS, S5_STATE), 0.1),
        "state_s5_im": nrm(ks[5], (N_ODD, DEC_BATCH, S5_GROUPS, S5_STATE), 0.1),
        "attn_norm_g": gain(ks[6], (N_EVEN, D_MODEL)),
        "w_in": nrm(ks[7], (N_EVEN, D_MODEL, 8 * MIX_HALF), D_MODEL ** -0.5),
        "ret_gn_g": gain(ks[8], (N_EVEN, MIX_HALF)),
        "hg_lb": nrm(ks[9], (DEPTH + 1, MIX_HALF), 0.5),
        "hg_gn_g": gain(ks[10], (N_EVEN, MIX_HALF)),
        "w_out": nrm(ks[11], (N_EVEN, D_MODEL, D_MODEL), D_MODEL ** -0.5),
        "ssm_norm_g": gain(ks[12], (N_ODD, D_MODEL)),
        "s5_lam_re": -0.5 + nrm(ks[13], (N_ODD, S5_GROUPS, S5_STATE), 0.01),
        "s5_lam_im": math.pi * n_idx + nrm(ks[14], (N_ODD, S5_GROUPS, S5_STATE), 0.01),
        "s5_log_dt": jax.random.uniform(ks[15], (N_ODD, S5_GROUPS), f32, math.log(1e-3), math.log(1e-1)),
        "s5_b_re": nrm(ks[16], (N_ODD, S5_GROUPS, S5_STATE, S5_GROUP), (2 * S5_GROUP) ** -0.5),
        "s5_b_im": nrm(ks[17], (N_ODD, S5_GROUPS, S5_STATE, S5_GROUP), (2 * S5_GROUP) ** -0.5),
        "s5_c_re": nrm(ks[18], (N_ODD, S5_GROUPS, S5_GROUP, S5_STATE), S5_STATE ** -0.5),
        "s5_c_im": nrm(ks[19], (N_ODD, S5_GROUPS, S5_GROUP, S5_STATE), S5_STATE ** -0.5),
        "s5_d": nrm(ks[20], (N_ODD, D_MODEL), 1.0),
        "w_glu_a": nrm(ks[21], (N_ODD, D_MODEL, D_MODEL), D_MODEL ** -0.5),
        "w_glu_b": nrm(ks[22], (N_ODD, D_MODEL, D_MODEL), D_MODEL ** -0.5),
        "ffn_norm_g": gain(ks[23], (DEPTH, D_MODEL)),
        "w_ffn_gate": nrm(ks[24], (DEPTH, D_MODEL, D_FF), D_MODEL ** -0.5),
        "w_ffn_up": nrm(ks[25], (DEPTH, D_MODEL, D_FF), D_MODEL ** -0.5),
        "w_ffn_down": nrm(ks[26], (DEPTH, D_FF, D_MODEL), D_FF ** -0.5),
        "final_norm_g": gain(ks[27], (D_MODEL,)),
    }


def reference(x_prompt, x_sample, state_ret, state_hgrn, state_s5_re, state_s5_im, attn_norm_g, w_in,
              ret_gn_g, hg_lb, hg_gn_g, w_out, ssm_norm_g, s5_lam_re, s5_lam_im, s5_log_dt, s5_b_re,
              s5_b_im, s5_c_re, s5_c_im, s5_d, w_glu_a, w_glu_b, ffn_norm_g, w_ffn_gate, w_ffn_up,
              w_ffn_down, final_norm_g):
    weights = (attn_norm_g, w_in, ret_gn_g, hg_lb, hg_gn_g, w_out, ssm_norm_g, s5_lam_re, s5_lam_im,
               s5_log_dt, s5_b_re, s5_b_im, s5_c_re, s5_c_im, s5_d, w_glu_a, w_glu_b, ffn_norm_g,
               w_ffn_gate, w_ffn_up, w_ffn_down, final_norm_g)
    fresh = lambda s: jnp.zeros((s.shape[0], BATCH) + s.shape[2:], s.dtype)
    y_prompt, ret_p, hg_p, s5r_p, s5i_p = _trunk(x_prompt, 0.0, fresh(state_ret), fresh(state_hgrn),
                                                 fresh(state_s5_re), fresh(state_s5_im), weights)
    y_sample, ret_s, hg_s, s5r_s, s5i_s = _trunk(x_sample, float(PAST_LEN), state_ret, state_hgrn,
                                                 state_s5_re, state_s5_im, weights)
    return (y_prompt, y_sample, ret_p, ret_s, hg_p, hg_s, s5r_p, s5i_p, s5r_s, s5i_s)
```

```cpp
#include <hip/hip_runtime.h>
#include <hip/hip_cooperative_groups.h>
#include <cstdio>
#include <cstdint>
namespace cg = cooperative_groups;
namespace pg8 {
#define PG8_LAS __attribute__((address_space(3)))
typedef unsigned short bf16_t;
typedef short bf16x8 __attribute__((ext_vector_type(8)));
typedef float f32x4 __attribute__((ext_vector_type(4)));
typedef unsigned u32x4 __attribute__((ext_vector_type(4)));
constexpr int BM = 256, BK = 64, HALF = 128, HTB = HALF * BK * 2  , STAGE_BYTES = 8 * HTB, NXCD = 8, WGM = 8;

__host__ __device__ __forceinline__ int lds_byte(int r, int c) { const int st = (r >> 4) * 2 + (c >> 5), rr = r & 15, cc = c & 31, ob = rr * 64 + cc * 2; return st * 1024 + (ob ^ (((ob >> 9) & 1) << 5)); }
__host__ __device__ __forceinline__ void stage_rc(int b, int& R, int& C) { const int st = b / 1024, sb = b % 1024, swz = sb ^ (((sb >> 9) & 1) << 5); R = (st >> 1) * 16 + swz / 64; C = (st & 1) * 32 + (swz % 64) / 2; }
__host__ __device__ __forceinline__ int perm32(int rho) { const int n = rho >> 4, i = rho & 15; return 8 * (i >> 2) + 4 * n + (i & 3); }

struct Unit { int pm, pn, kt0, nkt; };
struct Gemm { const bf16_t* A; const bf16_t* Bt; int M, N, K; };

struct StaticOrder {
    int nM, nN, nwg, G, c, nkt;
    __host__ __device__ __forceinline__ void init(int M, int N, int G_, int c_, int K) { nM = M / BM; nN = N / BM; nwg = nM * nN; G = G_; c = c_; nkt = K / BK; }
    __host__ __device__ __forceinline__ bool next(int i, Unit& u) const {
        const long L = (long)i * G + c; if (L >= nwg) return false;
        int wgid = (int)L; { const int q = nwg / NXCD, r = nwg % NXCD, xcd = wgid % NXCD, off = wgid / NXCD; wgid = (xcd < r ? xcd * (q + 1) : r * (q + 1) + (xcd - r) * q) + off; }
        const int nig = WGM * nN, gid = wgid / nig, fm = gid * WGM, gsz = (nM - fm) < WGM ? (nM - fm) : WGM;
        u.pm = fm + ((wgid % nig) % gsz); u.pn = (wgid % nig) / gsz; u.kt0 = 0; u.nkt = nkt; return true;
    }
    __device__ __forceinline__ void a_ready(const Unit&) const {}
    __device__ __forceinline__ void done(const Unit&) const {}
};
__device__ __forceinline__ unsigned cvt_pk_bf16(float lo, float hi) { unsigned r; asm volatile("v_cvt_pk_bf16_f32 %0, %1, %2" : "=v"(r) : "v"(lo), "v"(hi)); return r; }
typedef float f32x2 __attribute__((ext_vector_type(2)));
template <class Epi, class Sched, bool ALIGN_EPI = false, bool SP2 = false>
__device__ __forceinline__ void gemm_phase(PG8_LAS unsigned char* lds, const Gemm g, const Sched& S, const Epi& E) {
    const int tid = threadIdx.x, wid = __builtin_amdgcn_readfirstlane(tid >> 6), lane = tid & 63, wr = wid >> 2, wc = wid & 3, fr = lane & 15, fq = lane >> 4;
    const int K = g.K;
    unsigned voffA[2], voffB[2];
#pragma unroll
    for (int i = 0; i < 2; ++i) { int R, C; stage_rc(tid * 16 + i * 8192, R, C); const int Rb = Epi::PERM ? ((R & ~31) + perm32(R & 31)) : R;
        voffA[i] = (unsigned)(R * K + C) * 2u; voffB[i] = (unsigned)(Rb * K + C) * 2u; }
    const size_t kstep = (size_t)(BK * 2);
    const size_t hstep = (size_t)HALF * K * 2;
    const size_t tstep = 2 * hstep;
    const unsigned ldsw = (unsigned)wid * 1024u;
    const int aoff = lds_byte(wr * 64 + fr, fq * 8), boff = lds_byte(wc * 32 + fr, fq * 8);
#define PG8_SA(b, h) (((b) * 2 + (h)) * HTB)
#define PG8_SB(b, h) ((4 + (b) * 2 + (h)) * HTB)
#define PG8_STAGE(bufoff, gbase, voff) do { _Pragma("unroll") for (int _i = 0; _i < 2; ++_i) \
        __builtin_amdgcn_global_load_lds((const unsigned*)((const char*)(gbase) + (voff)[_i]), (PG8_LAS unsigned*)(lds + (bufoff) + ldsw + _i * 8192), 16, 0, 0); } while (0)
#define PG8_LDA(dst, b, h) do { _Pragma("unroll") for (int m = 0; m < 4; ++m) _Pragma("unroll") for (int k = 0; k < 2; ++k) dst[m][k] = *(const PG8_LAS bf16x8*)(lds + PG8_SA(b, h) + aoff + m * 2048 + k * 1024); } while (0)
#define PG8_LDB(dst, b, h) do { _Pragma("unroll") for (int n = 0; n < 2; ++n) _Pragma("unroll") for (int k = 0; k < 2; ++k) dst[n][k] = *(const PG8_LAS bf16x8*)(lds + PG8_SB(b, h) + boff + n * 2048 + k * 1024); } while (0)
#define PG8_MMA(ai, bj, At, Bt) do { __builtin_amdgcn_s_setprio(1); _Pragma("unroll") for (int m = 0; m < 4; ++m) _Pragma("unroll") for (int n = 0; n < 2; ++n) _Pragma("unroll") for (int k = 0; k < 2; ++k) \
        acc[ai][bj][m][n] = __builtin_amdgcn_mfma_f32_16x16x32_bf16(Bt[n][k], At[m][k], acc[ai][bj][m][n], 0, 0, 0); __builtin_amdgcn_s_setprio(0); } while (0)
#define PG8_WAIT_V(n) asm volatile("s_waitcnt vmcnt(" #n ")" ::: "memory")
#define PG8_WAIT_L(n) asm volatile("s_waitcnt lgkmcnt(" #n ")" ::: "memory")
#define PG8_BAR __builtin_amdgcn_s_barrier()
#define PG8_SCHED __builtin_amdgcn_sched_barrier(0)
    Unit cur, nxt; int ui = 0;
    if (!S.next(0, cur)) return;
    f32x4 acc[2][2][4][2];
#pragma unroll
    for (int a = 0; a < 2; ++a)
#pragma unroll
        for (int b = 0; b < 2; ++b)
#pragma unroll
            for (int m = 0; m < 4; ++m)
#pragma unroll
                for (int n = 0; n < 2; ++n) acc[a][b][m][n] = (f32x4){0.f, 0.f, 0.f, 0.f};
    bf16x8 At[4][2], B0[2][2], B1[2][2];
    const char* cA = (const char*)g.A + (size_t)cur.pm * tstep + (size_t)cur.kt0 * kstep; const char* cB = (const char*)g.Bt + (size_t)cur.pn * tstep + (size_t)cur.kt0 * kstep;
    S.a_ready(cur);
    if constexpr (SP2) {
        PG8_STAGE(PG8_SB(0, 0), cB, voffB); PG8_STAGE(PG8_SB(0, 1), cB + hstep, voffB); PG8_STAGE(PG8_SA(0, 0), cA, voffA); PG8_STAGE(PG8_SA(0, 1), cA + hstep, voffA);
        if (wr == 1) PG8_BAR;
        PG8_WAIT_V(2); PG8_BAR;
        PG8_STAGE(PG8_SB(1, 0), cB + kstep, voffB); PG8_STAGE(PG8_SA(1, 0), cA + kstep, voffA); PG8_STAGE(PG8_SB(1, 1), cB + hstep + kstep, voffB);
        PG8_WAIT_V(6); PG8_BAR;
    } else {
        PG8_STAGE(PG8_SB(0, 0), cB, voffB); PG8_STAGE(PG8_SA(0, 0), cA, voffA); PG8_STAGE(PG8_SB(0, 1), cB + hstep, voffB); PG8_STAGE(PG8_SA(0, 1), cA + hstep, voffA);
        if (wr == 1) PG8_BAR;
        PG8_WAIT_V(4); PG8_BAR;
        PG8_STAGE(PG8_SB(1, 0), cB + kstep, voffB); PG8_STAGE(PG8_SA(1, 0), cA + kstep, voffA); PG8_STAGE(PG8_SB(1, 1), cB + hstep + kstep, voffB);
        PG8_WAIT_V(6); PG8_BAR;
    }
    for (;;) {
        const bool has_next = S.next(ui + 1, nxt);
        const char* nA = has_next ? (const char*)g.A + (size_t)nxt.pm * tstep + (size_t)nxt.kt0 * kstep : cA; const char* nB = has_next ? (const char*)g.Bt + (size_t)nxt.pn * tstep + (size_t)nxt.kt0 * kstep : cB;
        const int nt = cur.nkt;
        for (int t = 0; t < nt; t += 2) {
            const bool last = (t == nt - 2);
            const char* a1 = cA + (size_t)(t + 1) * kstep;
            const char* a2 = last ? nA : cA + (size_t)(t + 2) * kstep; const char* b2 = last ? nB : cB + (size_t)(t + 2) * kstep;
            const char* a3 = a2 + kstep; const char* b3 = b2 + kstep;
            if (last && has_next) S.a_ready(nxt);
            if constexpr (SP2) {
            PG8_LDB(B0, 0, 0); PG8_LDB(B1, 0, 1); PG8_SCHED; PG8_LDA(At, 0, 0); PG8_STAGE(PG8_SA(1, 1), a1 + hstep, voffA);
            PG8_WAIT_V(8); PG8_WAIT_L(0); PG8_BAR; PG8_MMA(0, 0, At, B0); PG8_MMA(0, 1, At, B1); PG8_BAR; PG8_SCHED;
            PG8_LDA(At, 0, 1); PG8_STAGE(PG8_SB(0, 0), b2, voffB); PG8_STAGE(PG8_SB(0, 1), b2 + hstep, voffB); PG8_STAGE(PG8_SA(0, 0), a2, voffA);
            PG8_WAIT_V(8); PG8_WAIT_L(0); PG8_BAR; PG8_MMA(1, 0, At, B0); PG8_MMA(1, 1, At, B1); PG8_BAR; PG8_SCHED;
            PG8_LDB(B0, 1, 0); PG8_LDB(B1, 1, 1); PG8_SCHED; PG8_LDA(At, 1, 0); PG8_STAGE(PG8_SA(0, 1), a2 + hstep, voffA);
            PG8_WAIT_V(8); PG8_WAIT_L(0); PG8_BAR; PG8_MMA(0, 0, At, B0); PG8_MMA(0, 1, At, B1); PG8_BAR; PG8_SCHED;
            PG8_LDA(At, 1, 1); PG8_STAGE(PG8_SB(1, 0), b3, voffB); PG8_STAGE(PG8_SB(1, 1), b3 + hstep, voffB); PG8_STAGE(PG8_SA(1, 0), a3, voffA);
            PG8_WAIT_V(8); PG8_WAIT_L(0); PG8_BAR; PG8_MMA(1, 0, At, B0); PG8_MMA(1, 1, At, B1); PG8_BAR; PG8_SCHED;
            } else {
            PG8_LDB(B0, 0, 0); PG8_SCHED; PG8_LDA(At, 0, 0); PG8_STAGE(PG8_SA(1, 1), a1 + hstep, voffA);
            PG8_WAIT_L(8); PG8_BAR; PG8_WAIT_L(0); PG8_MMA(0, 0, At, B0); PG8_BAR; PG8_SCHED;
            PG8_LDB(B1, 0, 1); PG8_STAGE(PG8_SB(0, 0), b2, voffB);
            PG8_BAR; PG8_WAIT_L(0); PG8_MMA(0, 1, At, B1); PG8_BAR;
            PG8_LDA(At, 0, 1); PG8_STAGE(PG8_SA(0, 0), a2, voffA);
            PG8_BAR; PG8_WAIT_L(0); PG8_MMA(1, 0, At, B0); PG8_BAR; PG8_SCHED;
            PG8_STAGE(PG8_SB(0, 1), b2 + hstep, voffB);
            PG8_WAIT_V(6); PG8_BAR; PG8_MMA(1, 1, At, B1); PG8_BAR;
            PG8_LDB(B0, 1, 0); PG8_SCHED; PG8_LDA(At, 1, 0); PG8_STAGE(PG8_SA(0, 1), a2 + hstep, voffA);
            PG8_WAIT_L(8); PG8_BAR; PG8_WAIT_L(0); PG8_MMA(0, 0, At, B0); PG8_BAR; PG8_SCHED;
            PG8_LDB(B1, 1, 1); PG8_STAGE(PG8_SB(1, 0), b3, voffB);
            PG8_BAR; PG8_WAIT_L(0); PG8_MMA(0, 1, At, B1); PG8_BAR;
            PG8_LDA(At, 1, 1); PG8_STAGE(PG8_SA(1, 0), a3, voffA);
            PG8_BAR; PG8_WAIT_L(0); PG8_MMA(1, 0, At, B0); PG8_BAR; PG8_SCHED;
            PG8_STAGE(PG8_SB(1, 1), b3 + hstep, voffB);
            PG8_WAIT_V(6); PG8_BAR; PG8_MMA(1, 1, At, B1); PG8_BAR;
            }
        }
        if constexpr (ALIGN_EPI) { if (wr == 0) PG8_BAR; }
        if constexpr (!Epi::AFTER_DRAIN) { E(acc, cur, wr, wc, fr, fq); S.done(cur); }
        if (!has_next) break;
#pragma unroll
        for (int a = 0; a < 2; ++a)
#pragma unroll
            for (int b = 0; b < 2; ++b)
#pragma unroll
                for (int m = 0; m < 4; ++m)
#pragma unroll
                    for (int n = 0; n < 2; ++n) acc[a][b][m][n] = (f32x4){0.f, 0.f, 0.f, 0.f};
        cur = nxt; cA = nA; cB = nB; ++ui;
        if constexpr (ALIGN_EPI) { if (wr == 1) PG8_BAR; }
    }
    PG8_WAIT_V(0);
    if constexpr (!ALIGN_EPI) { if (wr == 0) PG8_BAR; }
    PG8_BAR;
    if constexpr (Epi::AFTER_DRAIN) { E.fused(acc, cur, wr, wc, fr, fq, lds, wid, lane); S.done(cur); }
#undef PG8_SA
#undef PG8_SB
#undef PG8_STAGE
#undef PG8_LDA
#undef PG8_LDB
#undef PG8_MMA
#undef PG8_WAIT_V
#undef PG8_WAIT_L
#undef PG8_BAR
#undef PG8_SCHED
}
}

#define LAS __attribute__((address_space(3)))
typedef pg8::bf16_t bf16_t;
typedef pg8::bf16x8 bf16x8;
typedef pg8::f32x4 f32x4;
typedef pg8::u32x4 u32x4;
typedef unsigned u32x2 __attribute__((ext_vector_type(2)));
typedef float f32x2 __attribute__((ext_vector_type(2)));

#ifndef SPLITK
#define SPLITK 22
#endif
#ifndef ONE_LAUNCH
#define ONE_LAUNCH 1
#endif

constexpr int D = 2048, TP = 8192, MR = 8320, MP = 8448, FF = 5632, NPH = 15;
constexpr float EPS = 1e-6f;
constexpr size_t MiB = (size_t)1 << 20;
constexpr size_t WS_COS = 0, WS_SIN = 1536 * 1024, WS_WIN = 4 * MiB, WS_WOUT = 36 * MiB, WS_WGLU = 44 * MiB, WS_WGU0 = 60 * MiB, WS_WGU1 = 104 * MiB,
                 WS_WDN0 = 148 * MiB, WS_WDN1 = 170 * MiB, WS_XRES = 192 * MiB, WS_H = 258 * MiB, WS_PROJ = 291 * MiB, PSZ = (size_t)MP * 1024 * 2,
                 WS_SSQ = 3 * MiB, WS_XB = 456 * MiB, WS_STR = 456 * MiB, WS_STH = 488 * MiB, WS_PART = 520 * MiB, WS_END = 552 * MiB;
constexpr size_t O_Y = 0, O_RETP = 17039360, O_RETS = 18087936, O_HGP = 51642368, O_HGS = 52166656, O_S5RP = 68943872, O_S5IP = 68976640, O_S5RS = 69009408,
                 O_S5IS = 70057984, O_END = 71106560;
constexpr int LDS_BYTES = 147456;

struct Args { const float* in[28]; float* out; unsigned char* ws; int ph_lo, ph_hi; };

#define LDS_WAIT() asm volatile("s_waitcnt lgkmcnt(0)" ::: "memory")
#define LDS_BARRIER() do { asm volatile("s_waitcnt lgkmcnt(0)" ::: "memory"); __builtin_amdgcn_s_barrier(); asm volatile("" ::: "memory"); } while (0)
#define MFMA16(a, b, c) __builtin_amdgcn_mfma_f32_16x16x32_bf16((a), (b), (c), 0, 0, 0)

__device__ __forceinline__ unsigned pkbf(float lo, float hi) { return pg8::cvt_pk_bf16(lo, hi); }
__device__ __forceinline__ float bflo(unsigned w) { return __uint_as_float(w << 16); }
__device__ __forceinline__ float bfhi(unsigned w) { return __uint_as_float(w & 0xffff0000u); }
__device__ __forceinline__ float bf2f(bf16_t b) { return __uint_as_float(((unsigned)b) << 16); }
__device__ __forceinline__ void st_bf4(bf16_t* p, f32x4 v) { u32x2 w; w.x = pkbf(v[0], v[1]); w.y = pkbf(v[2], v[3]); *(u32x2*)p = w; }
__device__ __forceinline__ float sigm(float x) { return __builtin_amdgcn_rcpf(1.f + __expf(-x)); }
__device__ __forceinline__ float silu(float x) { return x * sigm(x); }
__device__ __forceinline__ int opaque0() { int z; asm volatile("v_mov_b32 %0, 0" : "=v"(z)); return z; }
__device__ __forceinline__ float wave_sum(float v) {
#pragma unroll
    for (int o = 1; o < 64; o <<= 1) v += __shfl_xor(v, o);
    return v;
}
__device__ __forceinline__ float gelu_tanh(float x) {
    const float u = 0.7978845608028654f * (x + 0.044715f * x * x * x);
    const float e = __expf(2.f * u);
    const float th = 1.f - 2.f * __builtin_amdgcn_rcpf(e + 1.f);
    return 0.5f * x * (1.f + th);
}

struct EpiIn {
    static constexpr bool PERM = true, AFTER_DRAIN = false;
    bf16_t* P; float* PB; const float* rcos; const float* rsin; const float* hg_lb;
    __device__ __forceinline__ void operator()(const f32x4 (&acc)[2][2][4][2], const pg8::Unit& u, int wr, int wc, int fr, int fq) const {
        const int sec = u.pn >> 2, hd = u.pn & 3;
        const int rowb = u.pm * 256 + wr * 64 + fr;
        if (sec < 2) {
            bf16_t* O = P + (size_t)sec * (PSZ / 2); const float sc = sec == 0 ? 1.f : 0.0625f;
#pragma unroll
            for (int ai = 0; ai < 2; ++ai)
#pragma unroll
                for (int m = 0; m < 4; ++m) { const int row = rowb + ai * 128 + m * 16;
                    if (row < MR) { const int pidx = row < TP ? (row & 2047) : 2048;
                        const int i0 = wc * 32 + fq * 8; u32x4 w1, w2;
#pragma unroll
                        for (int n = 0; n < 2; ++n) {
                            const f32x4 c = *(const f32x4*)(rcos + pidx * 128 + i0 + 4 * n), s = *(const f32x4*)(rsin + pidx * 128 + i0 + 4 * n);
                            const f32x4 x1 = acc[ai][0][m][n], x2 = acc[ai][1][m][n];
                            const f32x4 o1 = (x1 * c - x2 * s) * sc, o2 = (x1 * s + x2 * c) * sc;
                            if (n == 0) { w1.x = pkbf(o1[0], o1[1]); w1.y = pkbf(o1[2], o1[3]); w2.x = pkbf(o2[0], o2[1]); w2.y = pkbf(o2[2], o2[3]); }
                            else { w1.z = pkbf(o1[0], o1[1]); w1.w = pkbf(o1[2], o1[3]); w2.z = pkbf(o2[0], o2[1]); w2.w = pkbf(o2[2], o2[3]); } }
                        bf16_t* rp = O + (size_t)row * 1024 + hd * 256 + i0;
                        __builtin_nontemporal_store(w1, (u32x4*)rp); __builtin_nontemporal_store(w2, (u32x4*)(rp + 128)); } }
        } else if (sec == 5) {
            bf16_t* OK_ = P + (size_t)5 * (PSZ / 2);
#pragma unroll
            for (int bj = 0; bj < 2; ++bj)
#pragma unroll
                for (int n = 0; n < 2; ++n) { const int col = hd * 256 + bj * 128 + wc * 32 + fq * 8 + n * 4;
                    const f32x4 a0 = *(const f32x4*)(hg_lb + col), a1 = *(const f32x4*)(hg_lb + 1024 + col), a2 = *(const f32x4*)(hg_lb + 2048 + col);
                    f32x4 lb;
#pragma unroll
                    for (int j = 0; j < 4; ++j) { const float mx = fmaxf(a0[j], fmaxf(a1[j], a2[j])); const float e0 = __expf(a0[j] - mx), e1 = __expf(a1[j] - mx), e2 = __expf(a2[j] - mx); lb[j] = e0 / (e0 + e1 + e2); }
#pragma unroll
                    for (int ai = 0; ai < 2; ++ai) { f32x4 lf[4];
#pragma unroll
                        for (int m = 0; m < 4; ++m) { const int row = rowb + ai * 128 + m * 16; f32x4 hk;
#pragma unroll
                            for (int j = 0; j < 4; ++j) { const float g = acc[ai][bj][m][n][j]; const float e = __expf(-g); const float sg = __builtin_amdgcn_rcpf(1.f + e);
                                const float f = lb[j] + (1.f - lb[j]) * sg; lf[m][j] = __logf(f); hk[j] = (1.f - lb[j]) * (e * sg); }
                            if (row < MR) st_bf4(OK_ + (size_t)row * 1024 + col, hk); }
                        if (u.pm < 32) {
                            f32x4 off = {0.f, 0.f, 0.f, 0.f};
#pragma unroll
                            for (int m = 0; m < 4; ++m) { f32x4 s = lf[m];
#pragma unroll
                                for (int d = 1; d < 16; d <<= 1) {
#pragma unroll
                                    for (int j = 0; j < 4; ++j) { const float t = __shfl_up(s[j], d, 16); if (fr >= d) s[j] += t; } }
                                s = s + off;
#pragma unroll
                                for (int j = 0; j < 4; ++j) off[j] = __shfl(s[j], 15, 16);
                                lf[m] = s; }
                        }
#pragma unroll
                        for (int m = 0; m < 4; ++m) { const int row = rowb + ai * 128 + m * 16; if (row < MR) *(f32x4*)(PB + (size_t)row * 1024 + col) = lf[m]; } } }
        } else {
            bf16_t* O = P + (size_t)sec * (PSZ / 2); const bool act = (sec == 3) | (sec == 4) | (sec == 7);
#pragma unroll
            for (int ai = 0; ai < 2; ++ai)
#pragma unroll
                for (int m = 0; m < 4; ++m) { const int row = rowb + ai * 128 + m * 16;
                    if (row < MR) {
#pragma unroll
                        for (int bj = 0; bj < 2; ++bj) { const int col = hd * 256 + bj * 128 + wc * 32 + fq * 8; f32x4 v0 = acc[ai][bj][m][0], v1 = acc[ai][bj][m][1];
                            if (act) {
#pragma unroll
                                for (int j = 0; j < 4; ++j) { v0[j] = silu(v0[j]); v1[j] = silu(v1[j]); } }
                            u32x4 wv; wv.x = pkbf(v0[0], v0[1]); wv.y = pkbf(v0[2], v0[3]); wv.z = pkbf(v1[0], v1[1]); wv.w = pkbf(v1[2], v1[3]);
                            __builtin_nontemporal_store(wv, (u32x4*)(O + (size_t)row * 1024 + col)); } } }
        }
    }
};
template <int MODE, bool SPLIT, bool FUSE> struct EpiRes {
    static constexpr bool PERM = false, AFTER_DRAIN = false;
    float* X; const float* xp; const float* xs; bf16_t* XB; float* SSQ;
    __device__ __forceinline__ void operator()(const f32x4 (&acc)[2][2][4][2], const pg8::Unit& u, int wr, int wc, int fr, int fq) const {
        const int rowb = u.pm * 256 + wr * 64 + fr;
        const bool at = false;
#pragma unroll
        for (int ai = 0; ai < 2; ++ai)
#pragma unroll
            for (int m = 0; m < 4; ++m) { const int row = rowb + ai * 128 + m * 16; float ss = 0.f;
                if (row < MR) { float* xr = X + (size_t)row * D;
                    if (MODE == 2) {
#pragma unroll
                        for (int n = 0; n < 2; ++n) { const int col = u.pn * 128 + wc * 32 + n * 16 + fq * 4; const f32x4 a = acc[ai][0][m][n], b = acc[ai][1][m][n]; f32x4 r = *(const f32x4*)(xr + col);
#pragma unroll
                            for (int j = 0; j < 4; ++j) r[j] += a[j] * sigm(b[j]);
                            *(f32x4*)(xr + col) = r;
                            if (FUSE) { if (XB) st_bf4(XB + (size_t)row * D + col, r); ss += (r[0] * r[0] + r[1] * r[1]) + (r[2] * r[2] + r[3] * r[3]); } }
                    } else if (at) {
#pragma unroll
                        for (int bj = 0; bj < 2; ++bj)
#pragma unroll
                            for (int n = 0; n < 2; ++n) { const int col = u.pn * 256 + bj * 128 + wc * 32 + n * 16 + fq * 4;
#pragma unroll
                                for (int j = 0; j < 4; ++j) __hip_atomic_fetch_add(xr + col + j, acc[ai][bj][m][n][j], __ATOMIC_RELAXED, __HIP_MEMORY_SCOPE_AGENT); }
                    } else { const float* br = MODE == 0 ? (row < TP ? xp + (size_t)row * D : xs + (size_t)(row - TP) * D) : xr;
#pragma unroll
                        for (int bj = 0; bj < 2; ++bj)
#pragma unroll
                            for (int n = 0; n < 2; ++n) { const int col = u.pn * 256 + bj * 128 + wc * 32 + n * 16 + fq * 4; const f32x4 r = *(const f32x4*)(br + col) + acc[ai][bj][m][n]; *(f32x4*)(xr + col) = r;
                                if (FUSE) { if (XB) st_bf4(XB + (size_t)row * D + col, r); ss += (r[0] * r[0] + r[1] * r[1]) + (r[2] * r[2] + r[3] * r[3]); } } } }
                if (FUSE) { ss += __shfl_xor(ss, 16); ss += __shfl_xor(ss, 32); if (fq == 0 && row < MR) __hip_atomic_fetch_add(SSQ + row, ss, __ATOMIC_RELAXED, __HIP_MEMORY_SCOPE_AGENT); } }
    }
};
struct SplitOrder {
    pg8::StaticOrder so; int nN, NS, nkt_all, G, c, nmain;
    __device__ __forceinline__ void init(int N, int K, int NS_, int G_, int c_) { so.init(TP, N, G_, c_, K); nN = N / 256; NS = NS_; nkt_all = K / 64; G = G_; c = c_; nmain = 32 * nN; }
    __device__ __forceinline__ bool next(int i, pg8::Unit& u) const {
        const long L = (long)i * G + c; const bool mn = L < nmain; const long Ls = L - nmain; if (!mn && Ls >= (long)nN * NS) return false;
        int wgid = mn ? (int)L : 0; { const int nwg = nmain, q = nwg / pg8::NXCD, r = nwg % pg8::NXCD, xcd = wgid % pg8::NXCD, off = wgid / pg8::NXCD; wgid = (xcd < r ? xcd * (q + 1) : r * (q + 1) + (xcd - r) * q) + off; }
        const int nig = pg8::WGM * nN, gid = wgid / nig, fm = gid * pg8::WGM, gsz = (32 - fm) < pg8::WGM ? (32 - fm) : pg8::WGM;
        const int pm_m = fm + ((wgid % nig) % gsz), pn_m = (wgid % nig) / gsz; const int ks = mn ? 0 : (int)(Ls / nN), sub = nkt_all / NS;
        u.pm = mn ? pm_m : 32; u.pn = mn ? pn_m : (int)(Ls % nN); u.nkt = mn ? nkt_all : sub; u.kt0 = ks * sub; return true; }
    __device__ __forceinline__ void a_ready(const pg8::Unit&) const {}
    __device__ __forceinline__ void done(const pg8::Unit&) const {}
};
template <class E> struct EpiMux {
    static constexpr bool PERM = false, AFTER_DRAIN = false;
    E e; float* PART; int N;
    __device__ __forceinline__ void operator()(const f32x4 (&acc)[2][2][4][2], const pg8::Unit& u, int wr, int wc, int fr, int fq) const {
        if (u.pm == 32) { const int ks = u.kt0 / u.nkt; float* pb = PART + ((size_t)ks * 128 + wr * 64 + fr) * N + u.pn * 256 + wc * 32 + fq * 4;
#pragma unroll
            for (int m = 0; m < 4; ++m)
#pragma unroll
                for (int bj = 0; bj < 2; ++bj)
#pragma unroll
                    for (int n = 0; n < 2; ++n) *(f32x4*)(pb + (size_t)(m * 16) * N + bj * 128 + n * 16) = acc[0][bj][m][n];
        } else e(acc, u, wr, wc, fr, fq);
    }
};
template <int NS> __device__ __forceinline__ void reduce_partials(float* PART, int N, int G, int bid) {
    const size_t slab = (size_t)128 * N; const int nv = (int)(slab / 4);
    for (int idx = bid * 512 + (int)threadIdx.x; idx < nv; idx += G * 512) { f32x4 v[NS];
#pragma unroll
        for (int ks = 0; ks < NS; ++ks) v[ks] = *(const f32x4*)(PART + (size_t)ks * slab + (size_t)idx * 4);
        f32x4 t = v[0];
#pragma unroll
        for (int ks = 1; ks < NS; ++ks) t = t + v[ks];
        *(f32x4*)(PART + (size_t)idx * 4) = t; }
}
template <class E> __device__ __forceinline__ void finalize_sample(const E& e, const float* PART, int N, int NS, int G, int bid) {
    const int tid = threadIdx.x + opaque0(), lane = tid & 63, wid = __builtin_amdgcn_readfirstlane(tid >> 6), wr = wid >> 2, wc = wid & 3, fr = lane & 15, fq = lane >> 4;
    for (int pn = bid; pn < N / 256; pn += G) {
        f32x4 acc[2][2][4][2];
#pragma unroll
        for (int a = 0; a < 2; ++a)
#pragma unroll
            for (int b = 0; b < 2; ++b)
#pragma unroll
                for (int m = 0; m < 4; ++m)
#pragma unroll
                    for (int n = 0; n < 2; ++n) acc[a][b][m][n] = (f32x4){0.f, 0.f, 0.f, 0.f};
        const float* pb = PART + ((size_t)wr * 64 + fr) * N + pn * 256 + wc * 32 + fq * 4;
#pragma unroll 1
        for (int ks = 0; ks < NS; ++ks) {
#pragma unroll
            for (int m = 0; m < 4; ++m)
#pragma unroll
                for (int bj = 0; bj < 2; ++bj)
#pragma unroll
                    for (int n = 0; n < 2; ++n) acc[0][bj][m][n] = acc[0][bj][m][n] + *(const f32x4*)(pb + ((size_t)ks * 128 + m * 16) * N + bj * 128 + n * 16); }
        pg8::Unit u; u.pm = 32; u.pn = pn; u.kt0 = 0; u.nkt = 1;
        e(acc, u, wr, wc, fr, fq);
    }
}
struct EpiGU {
    static constexpr bool PERM = true, AFTER_DRAIN = false;
    bf16_t* A; const float* SSQ;
    __device__ __forceinline__ void operator()(const f32x4 (&acc)[2][2][4][2], const pg8::Unit& u, int wr, int wc, int fr, int fq) const {
        const int rowb = u.pm * 256 + wr * 64 + fr;
        const int col = u.pn * 128 + wc * 32 + fq * 8;
#pragma unroll
        for (int ai = 0; ai < 2; ++ai)
#pragma unroll
            for (int m = 0; m < 4; ++m) { const int row = rowb + ai * 128 + m * 16;
                if (row < MR) { const float rstd = rsqrtf(SSQ[row] * (1.f / D) + EPS);
                    const f32x4 g0 = acc[ai][0][m][0] * rstd, g1 = acc[ai][0][m][1] * rstd, u0 = acc[ai][1][m][0] * rstd, u1 = acc[ai][1][m][1] * rstd; f32x4 v0, v1;
#pragma unroll
                    for (int j = 0; j < 4; ++j) { v0[j] = silu(g0[j]) * u0[j]; v1[j] = silu(g1[j]) * u1[j]; }
                    u32x4 wv; wv.x = pkbf(v0[0], v0[1]); wv.y = pkbf(v0[2], v0[3]); wv.z = pkbf(v1[0], v1[1]); wv.w = pkbf(v1[2], v1[3]);
                    __builtin_nontemporal_store(wv, (u32x4*)(A + (size_t)row * FF + col)); } }
    }
};

__device__ __forceinline__ void transpose_item(const float* W, int K, int N, bf16_t* WT, int dst_row, LAS float* scr, int k0, int n0, int lane, const float* gain) {
#pragma unroll
    for (int i = 0; i < 32; ++i) { const int kk = 2 * i + (lane >> 5); scr[kk * 33 + (lane & 31)] = __builtin_nontemporal_load(W + (size_t)(k0 + kk) * N + n0 + (lane & 31)); }
    LDS_WAIT();
    const int c = lane & 7;
    f32x4 g0 = {1.f, 1.f, 1.f, 1.f}, g1 = g0;
    if (gain) { g0 = *(const f32x4*)(gain + k0 + 8 * c); g1 = *(const f32x4*)(gain + k0 + 8 * c + 4); }
#pragma unroll
    for (int j = 0; j < 4; ++j) { const int n = (lane >> 3) + 8 * j; const LAS float* s = scr + (8 * c) * 33 + n;
        u32x4 o; o.x = pkbf(s[0 * 33] * g0[0], s[1 * 33] * g0[1]); o.y = pkbf(s[2 * 33] * g0[2], s[3 * 33] * g0[3]); o.z = pkbf(s[4 * 33] * g1[0], s[5 * 33] * g1[1]); o.w = pkbf(s[6 * 33] * g1[2], s[7 * 33] * g1[3]);
        *(u32x4*)(WT + (size_t)(dst_row + n) * K + k0 + 8 * c) = o; }
    LDS_WAIT();
}
__device__ __forceinline__ void prep_matrix(const float* W, int K, int N, bf16_t* WT, int mode, int sel, LAS float* scr, int gw, int NGW, int lane_, const float* gain = nullptr) {
    const int lane = lane_ + opaque0();
    const int nblk = N / 32, items = (K / 64) * nblk;
    for (int it = gw; it < items; it += NGW) { const int kb = it / nblk, nb = it - kb * nblk, n0 = nb * 32;
        const int dst = mode ? ((n0 >> 7) * 256 + sel * 128 + (n0 & 127)) : n0;
        transpose_item(W, K, N, WT, dst, scr, kb * 64, n0, lane, gain); }
}
template <bool OUTF> __device__ __forceinline__ void rms_rows(const float* xa, const float* xb, const float* g, void* out, int gw, int NGW, int lane) {
    for (int row = gw; row < MR; row += NGW) {
        const float* xr = (xb != nullptr && row >= TP) ? xb + (size_t)(row - TP) * D : xa + (size_t)row * D;
        f32x4 v[8]; float s = 0.f;
#pragma unroll
        for (int j = 0; j < 8; ++j) { v[j] = OUTF ? __builtin_nontemporal_load((const f32x4*)(xr + 4 * lane + 256 * j)) : *(const f32x4*)(xr + 4 * lane + 256 * j); s += (v[j][0] * v[j][0] + v[j][1] * v[j][1]) + (v[j][2] * v[j][2] + v[j][3] * v[j][3]); }
        const float rstd = rsqrtf(wave_sum(s) * (1.f / D) + EPS);
#pragma unroll
        for (int j = 0; j < 8; ++j) { const f32x4 gg = *(const f32x4*)(g + 4 * lane + 256 * j); const f32x4 o = v[j] * rstd * gg;
            if (OUTF) __builtin_nontemporal_store(o, (f32x4*)((float*)out + (size_t)row * D + 4 * lane + 256 * j)); else st_bf4((bf16_t*)out + (size_t)row * D + 4 * lane + 256 * j, o); }
    }
}


struct MixPtrs { const bf16_t *PQ, *PK, *PV, *PRG, *PHQ, *PHK, *PHV, *PGG; const float* PB; bf16_t *STR, *STH, *MIX; };

__device__ __forceinline__ void ret_scan_unit(const MixPtrs& p, float* out_state, LAS unsigned char* lds, int unit) {
    const int tid = threadIdx.x + opaque0(), lane = tid & 63, w = __builtin_amdgcn_readfirstlane(tid >> 6), fr = lane & 15, fq = lane >> 4;
    const int dvs = unit & 3, h = (unit >> 2) & 3, b = unit >> 4;
    LAS bf16_t* VT = (LAS bf16_t*)lds;
    LAS bf16_t* KT = (LAS bf16_t*)(lds + 64 * 136 * 2);
    const float gamma = 1.f - exp2f(-5.f - (float)h), lg2 = log2f(gamma), cdec = exp2f(128.f * lg2);
    f32x4 acc[4][2];
#pragma unroll
    for (int a = 0; a < 4; ++a)
#pragma unroll
        for (int c = 0; c < 2; ++c) acc[a][c] = (f32x4){0.f, 0.f, 0.f, 0.f};
    u32x4 rk[8], rv[2];
#define RT_LOAD(n_) do { const int r0_ = b * 2048 + (n_) * 128; \
        _Pragma("unroll") for (int it = 0; it < 8; ++it) { const int id = tid + it * 512; rk[it] = *(const u32x4*)(p.PK + (size_t)(r0_ + (id & 127)) * 1024 + h * 256 + (id >> 7) * 8); } \
        _Pragma("unroll") for (int it = 0; it < 2; ++it) { const int id = tid + it * 512; rv[it] = *(const u32x4*)(p.PV + (size_t)(r0_ + (id & 127)) * 1024 + h * 256 + dvs * 64 + (id >> 7) * 8); } } while (0)
    RT_LOAD(0);
    const float kd = exp2f((float)(127 - (tid & 127)) * lg2);
    for (int n = 0; n < 16; ++n) {
        if (n > 0) { bf16_t* st = p.STR + ((size_t)((b * 4 + h) * 16 + n)) * 65536;
#pragma unroll
            for (int mt = 0; mt < 4; ++mt)
#pragma unroll
                for (int nt = 0; nt < 2; ++nt) st_bf4(st + (size_t)(dvs * 64 + mt * 16 + fr) * 256 + w * 32 + nt * 16 + fq * 4, acc[mt][nt]); }
        LDS_BARRIER();
#pragma unroll
        for (int it = 0; it < 8; ++it) { const int id = tid + it * 512, t = id & 127, cc = id >> 7; const u32x4 v = rk[it];
            LAS bf16_t* d = KT + (cc * 8) * 136 + t;
            const unsigned w0 = pkbf(bflo(v.x) * kd, bfhi(v.x) * kd), w1 = pkbf(bflo(v.y) * kd, bfhi(v.y) * kd), w2 = pkbf(bflo(v.z) * kd, bfhi(v.z) * kd), w3 = pkbf(bflo(v.w) * kd, bfhi(v.w) * kd);
            d[0 * 136] = (bf16_t)w0; d[1 * 136] = (bf16_t)(w0 >> 16); d[2 * 136] = (bf16_t)w1; d[3 * 136] = (bf16_t)(w1 >> 16);
            d[4 * 136] = (bf16_t)w2; d[5 * 136] = (bf16_t)(w2 >> 16); d[6 * 136] = (bf16_t)w3; d[7 * 136] = (bf16_t)(w3 >> 16); }
#pragma unroll
        for (int it = 0; it < 2; ++it) { const int id = tid + it * 512, t = id & 127, cc = id >> 7; const u32x4 v = rv[it];
            LAS bf16_t* d = VT + (cc * 8) * 136 + t;
            d[0 * 136] = (bf16_t)v.x; d[1 * 136] = (bf16_t)(v.x >> 16); d[2 * 136] = (bf16_t)v.y; d[3 * 136] = (bf16_t)(v.y >> 16);
            d[4 * 136] = (bf16_t)v.z; d[5 * 136] = (bf16_t)(v.z >> 16); d[6 * 136] = (bf16_t)v.w; d[7 * 136] = (bf16_t)(v.w >> 16); }
        if (n + 1 < 16) RT_LOAD(n + 1);
        LDS_BARRIER();
#pragma unroll
        for (int a = 0; a < 4; ++a)
#pragma unroll
            for (int c = 0; c < 2; ++c) acc[a][c] = acc[a][c] * cdec;
#pragma unroll
        for (int ks = 0; ks < 4; ++ks) { bf16x8 af[4], bfr[2];
#pragma unroll
            for (int mt = 0; mt < 4; ++mt) af[mt] = *(const LAS bf16x8*)(VT + (mt * 16 + fr) * 136 + ks * 32 + fq * 8);
#pragma unroll
            for (int nt = 0; nt < 2; ++nt) bfr[nt] = *(const LAS bf16x8*)(KT + (w * 32 + nt * 16 + fr) * 136 + ks * 32 + fq * 8);
#pragma unroll
            for (int mt = 0; mt < 4; ++mt)
#pragma unroll
                for (int nt = 0; nt < 2; ++nt) acc[mt][nt] = MFMA16(bfr[nt], af[mt], acc[mt][nt]); }
    }
#undef RT_LOAD
    float* os = out_state + (size_t)(b * 4 + h) * 65536;
#pragma unroll
    for (int mt = 0; mt < 4; ++mt)
#pragma unroll
        for (int nt = 0; nt < 2; ++nt)
#pragma unroll
            for (int j = 0; j < 4; ++j) os[(size_t)(w * 32 + nt * 16 + fq * 4 + j) * 256 + dvs * 64 + mt * 16 + fr] = acc[mt][nt][j];
    __syncthreads();
}

__device__ __forceinline__ void hg_scan_unit(const MixPtrs& p, float* out_state, LAS unsigned char* lds, int unit) {
    const int tid = threadIdx.x + opaque0(), lane = tid & 63, w = __builtin_amdgcn_readfirstlane(tid >> 6), fr = lane & 15, fq = lane >> 4;
    const int h = unit & 7, b = unit >> 3;
    LAS bf16_t* VT = (LAS bf16_t*)lds;
    LAS bf16_t* KT = (LAS bf16_t*)(lds + 128 * 72 * 2);
    f32x4 acc[8];
#pragma unroll
    for (int a = 0; a < 8; ++a) acc[a] = (f32x4){0.f, 0.f, 0.f, 0.f};
    u32x4 rk[2], rv[2]; f32x4 rb0[2], rb1[2], rl0[2], rl1[2], rbl;
#define HG_LOAD(n_) do { const int r0_ = b * 2048 + (n_) * 64; \
        _Pragma("unroll") for (int it = 0; it < 2; ++it) { const int id = tid + it * 512, t = id & 63, cc = id >> 6; \
            const size_t go = (size_t)(r0_ + t) * 1024 + h * 128 + cc * 8, gl = (size_t)(r0_ + 63) * 1024 + h * 128 + cc * 8; \
            rk[it] = *(const u32x4*)(p.PHK + go); rb0[it] = *(const f32x4*)(p.PB + go); rb1[it] = *(const f32x4*)(p.PB + go + 4); rl0[it] = *(const f32x4*)(p.PB + gl); rl1[it] = *(const f32x4*)(p.PB + gl + 4); } \
        _Pragma("unroll") for (int it = 0; it < 2; ++it) { const int id = tid + it * 512; rv[it] = *(const u32x4*)(p.PHV + (size_t)(r0_ + (id & 63)) * 1024 + h * 128 + (id >> 6) * 8); } \
        rbl = *(const f32x4*)(p.PB + (size_t)(r0_ + 63) * 1024 + h * 128 + w * 16 + fq * 4); } while (0)
    HG_LOAD(0);
    for (int n = 0; n < 32; ++n) {
        if (n > 0) { bf16_t* st = p.STH + ((size_t)((b * 8 + h) * 32 + n)) * 16384;
#pragma unroll
            for (int mt = 0; mt < 8; ++mt) st_bf4(st + (size_t)(mt * 16 + fr) * 128 + w * 16 + fq * 4, acc[mt]); }
        LDS_BARRIER();
#pragma unroll
        for (int it = 0; it < 2; ++it) { const int id = tid + it * 512, t = id & 63, cc = id >> 6;
            const u32x4 v = rk[it]; const f32x4 b0 = rb0[it], b1 = rb1[it], l0 = rl0[it], l1 = rl1[it];
            LAS bf16_t* d = KT + (cc * 8) * 72 + t;
            const unsigned w0 = pkbf(bflo(v.x) * __expf(l0[0] - b0[0]), bfhi(v.x) * __expf(l0[1] - b0[1])), w1 = pkbf(bflo(v.y) * __expf(l0[2] - b0[2]), bfhi(v.y) * __expf(l0[3] - b0[3]));
            const unsigned w2 = pkbf(bflo(v.z) * __expf(l1[0] - b1[0]), bfhi(v.z) * __expf(l1[1] - b1[1])), w3 = pkbf(bflo(v.w) * __expf(l1[2] - b1[2]), bfhi(v.w) * __expf(l1[3] - b1[3]));
            d[0 * 72] = (bf16_t)w0; d[1 * 72] = (bf16_t)(w0 >> 16); d[2 * 72] = (bf16_t)w1; d[3 * 72] = (bf16_t)(w1 >> 16);
            d[4 * 72] = (bf16_t)w2; d[5 * 72] = (bf16_t)(w2 >> 16); d[6 * 72] = (bf16_t)w3; d[7 * 72] = (bf16_t)(w3 >> 16); }
#pragma unroll
        for (int it = 0; it < 2; ++it) { const int id = tid + it * 512, t = id & 63, cc = id >> 6; const u32x4 v = rv[it];
            LAS bf16_t* d = VT + (cc * 8) * 72 + t;
            d[0 * 72] = (bf16_t)v.x; d[1 * 72] = (bf16_t)(v.x >> 16); d[2 * 72] = (bf16_t)v.y; d[3 * 72] = (bf16_t)(v.y >> 16);
            d[4 * 72] = (bf16_t)v.z; d[5 * 72] = (bf16_t)(v.z >> 16); d[6 * 72] = (bf16_t)v.w; d[7 * 72] = (bf16_t)(v.w >> 16); }
        f32x4 e4;
#pragma unroll
        for (int j = 0; j < 4; ++j) e4[j] = __expf(rbl[j]);
        if (n + 1 < 32) HG_LOAD(n + 1);
        LDS_BARRIER();
#pragma unroll
        for (int a = 0; a < 8; ++a) acc[a] = acc[a] * e4;
#pragma unroll
        for (int ks = 0; ks < 2; ++ks) { const bf16x8 bfr = *(const LAS bf16x8*)(KT + (w * 16 + fr) * 72 + ks * 32 + fq * 8);
#pragma unroll
            for (int mt = 0; mt < 8; ++mt) { const bf16x8 af = *(const LAS bf16x8*)(VT + (mt * 16 + fr) * 72 + ks * 32 + fq * 8); acc[mt] = MFMA16(bfr, af, acc[mt]); } }
    }
#undef HG_LOAD
    float* os = out_state + (size_t)(b * 8 + h) * 16384;
#pragma unroll
    for (int mt = 0; mt < 8; ++mt)
#pragma unroll
        for (int j = 0; j < 4; ++j) os[(size_t)(w * 16 + fq * 4 + j) * 128 + mt * 16 + fr] = acc[mt][j];
    __syncthreads();
}

template <bool RET> __device__ __forceinline__ void sample_unit(const MixPtrs& p, const float* s_in, float* s_out, const float* gn_g, LAS unsigned char* lds, int unit) {
    constexpr int DK = RET ? 256 : 128, NH = RET ? 4 : 8, TX = DK / 4, NTY = 512 / TX, NIT = DK / NTY;
    const int tid = threadIdx.x, tx = tid % TX, ty = tid / TX;
    const int h = unit % NH, bs = unit / NH, row = TP + bs;
    const bf16_t* q = (RET ? p.PQ : p.PHQ) + (size_t)row * 1024 + h * DK;
    const bf16_t* k = (RET ? p.PK : p.PHK) + (size_t)row * 1024 + h * DK;
    const bf16_t* v = (RET ? p.PV : p.PHV) + (size_t)row * 1024 + h * DK;
    const float* fb = p.PB + (size_t)row * 1024 + h * DK;
    const u32x2 vv = *(const u32x2*)(v + 4 * tx);
    const f32x4 v4 = {bflo(vv.x), bfhi(vv.x), bflo(vv.y), bfhi(vv.y)};
    const float gamma = 1.f - exp2f(-5.f - (float)h);
    const size_t sb = (size_t)unit * DK * DK;
    LAS f32x4* cf = (LAS f32x4*)(lds + 8192);
    if (tid < DK) { f32x4 c; c[0] = RET ? gamma : __expf(fb[tid]); c[1] = bf2f(k[tid]); c[2] = bf2f(q[tid]); c[3] = 0.f; cf[tid] = c; }
    __syncthreads();
    f32x4 o = {0.f, 0.f, 0.f, 0.f};
#pragma unroll 8
    for (int i = 0; i < NIT; ++i) { const int dk = ty + NTY * i;
        const f32x4 c = cf[dk]; const float dec = c[0], kk = c[1], qq = c[2];
        const f32x4 s = __builtin_nontemporal_load((const f32x4*)(s_in + sb + (size_t)dk * DK + 4 * tx));
        const f32x4 sn = s * dec + v4 * kk;
        __builtin_nontemporal_store(sn, (f32x4*)(s_out + sb + (size_t)dk * DK + 4 * tx));
        o = o + sn * qq; }
    LAS f32x4* red = (LAS f32x4*)lds;
    red[ty * TX + tx] = o;
    __syncthreads();
    if (tid < 64) {
        f32x4 t = {0.f, 0.f, 0.f, 0.f};
        if (tid < TX) {
#pragma unroll 4
            for (int y = 0; y < NTY; ++y) t = t + red[y * TX + tid]; }
        const int col = h * DK + 4 * tid;
        if (RET) { const float mu = wave_sum((t[0] + t[1]) + (t[2] + t[3])) * (1.f / DK); const f32x4 dlt = t - mu;
            const float var = wave_sum((dlt[0] * dlt[0] + dlt[1] * dlt[1]) + (dlt[2] * dlt[2] + dlt[3] * dlt[3])) * (1.f / DK); const float rs = rsqrtf(var + EPS);
            const f32x4 g = *(const f32x4*)(gn_g + col); const u32x2 gw = *(const u32x2*)(p.PRG + (size_t)row * 1024 + col);
            const f32x4 gate = {bflo(gw.x), bfhi(gw.x), bflo(gw.y), bfhi(gw.y)};
            st_bf4(p.MIX + (size_t)row * D + col, dlt * rs * g * gate);
        } else { const float ss = wave_sum((t[0] * t[0] + t[1] * t[1]) + (t[2] * t[2] + t[3] * t[3])) * (1.f / DK); const float rs = rsqrtf(ss + EPS);
            if (tid < TX) { const f32x4 g = *(const f32x4*)(gn_g + col); const u32x2 gw = *(const u32x2*)(p.PGG + (size_t)row * 1024 + col);
                const f32x4 gate = {bflo(gw.x), bfhi(gw.x), bflo(gw.y), bfhi(gw.y)};
                st_bf4(p.MIX + (size_t)row * D + 1024 + col, t * rs * g * gate); } }
    }
    __syncthreads();
}


template <int HALF> __device__ __forceinline__ void ret_qs_half(f32x4 (&o)[16], const bf16x8 (&qf)[8], LAS bf16_t* R0, const bf16_t* st, int tid, int fr, int fq) {
    __syncthreads();
    for (int id = tid; id < 128 * 32; id += 512) { const int rr = id >> 5, cc = id & 31; *(LAS u32x4*)(R0 + rr * 264 + cc * 8) = __builtin_nontemporal_load((const u32x4*)(st + (size_t)(HALF * 128 + rr) * 256 + cc * 8)); }
    __syncthreads();
#pragma unroll
    for (int ks = 0; ks < 8; ++ks) {
#pragma unroll
        for (int nt = 0; nt < 8; ++nt) { const bf16x8 bfr = *(const LAS bf16x8*)(R0 + (nt * 16 + fr) * 264 + ks * 32 + fq * 8); o[HALF * 8 + nt] = MFMA16(bfr, qf[ks], o[HALF * 8 + nt]); }
        __builtin_amdgcn_sched_barrier(0); }
}
__device__ __forceinline__ void ret_out_unit(const MixPtrs& p, const float* gn_g, LAS unsigned char* lds, int unit) {
    const int tid = threadIdx.x + opaque0(), lane = tid & 63, w = __builtin_amdgcn_readfirstlane(tid >> 6), fr = lane & 15, fq = lane >> 4;
    const int n = unit & 15, h = (unit >> 4) & 3, b = unit >> 6;
    const int r0 = b * 2048 + n * 128, i = 16 * w + fr, row = r0 + i;
    LAS bf16_t* R0 = (LAS bf16_t*)lds;
    LAS bf16_t* R1 = (LAS bf16_t*)(lds + 69632);
    const float gamma = 1.f - exp2f(-5.f - (float)h), lg2 = log2f(gamma);
    bf16x8 qf[8];
#pragma unroll
    for (int ks = 0; ks < 8; ++ks) qf[ks] = *(const bf16x8*)(p.PQ + (size_t)row * 1024 + h * 256 + ks * 32 + fq * 8);
    for (int id = tid; id < 128 * 32; id += 512) { const int rr = id >> 5, cc = id & 31; *(LAS u32x4*)(R0 + rr * 264 + cc * 8) = *(const u32x4*)(p.PK + (size_t)(r0 + rr) * 1024 + h * 256 + cc * 8); }
    __syncthreads();
    {   f32x4 att[8];
#pragma unroll
        for (int nt = 0; nt < 8; ++nt) att[nt] = (f32x4){0.f, 0.f, 0.f, 0.f};
#pragma unroll
        for (int ks = 0; ks < 8; ++ks) {
#pragma unroll
            for (int nt = 0; nt < 8; ++nt) { const bf16x8 bfr = *(const LAS bf16x8*)(R0 + (nt * 16 + fr) * 264 + ks * 32 + fq * 8); att[nt] = MFMA16(bfr, qf[ks], att[nt]); }
            __builtin_amdgcn_sched_barrier(0); }
#pragma unroll
        for (int nt = 0; nt < 8; ++nt) { f32x4 a;
#pragma unroll
            for (int jj = 0; jj < 4; ++jj) { const int j = nt * 16 + fq * 4 + jj; a[jj] = (j <= i) ? att[nt][jj] * exp2f(-(float)(j + 1) * lg2) : 0.f; }
            u32x2 wv; wv.x = pkbf(a[0], a[1]); wv.y = pkbf(a[2], a[3]); *(LAS u32x2*)(R1 + i * 136 + nt * 16 + fq * 4) = wv; } }
    __syncthreads();
    for (int id = tid; id < 128 * 32; id += 512) { const int t = id & 127, cc = id >> 7;
        const u32x4 v = *(const u32x4*)(p.PV + (size_t)(r0 + t) * 1024 + h * 256 + cc * 8);
        LAS bf16_t* d = R0 + (cc * 8) * 136 + t;
        d[0 * 136] = (bf16_t)v.x; d[1 * 136] = (bf16_t)(v.x >> 16); d[2 * 136] = (bf16_t)v.y; d[3 * 136] = (bf16_t)(v.y >> 16);
        d[4 * 136] = (bf16_t)v.z; d[5 * 136] = (bf16_t)(v.z >> 16); d[6 * 136] = (bf16_t)v.w; d[7 * 136] = (bf16_t)(v.w >> 16); }
    __syncthreads();
    f32x4 o[16];
#pragma unroll
    for (int nt = 0; nt < 16; ++nt) o[nt] = (f32x4){0.f, 0.f, 0.f, 0.f};
#pragma unroll
    for (int ks = 0; ks < 4; ++ks) { const bf16x8 af = *(const LAS bf16x8*)(R1 + i * 136 + ks * 32 + fq * 8);
#pragma unroll
        for (int nt = 0; nt < 16; ++nt) { const bf16x8 bfr = *(const LAS bf16x8*)(R0 + (nt * 16 + fr) * 136 + ks * 32 + fq * 8); o[nt] = MFMA16(bfr, af, o[nt]); if ((nt & 7) == 7) __builtin_amdgcn_sched_barrier(0); } }
    if (n > 0) { const bf16_t* st = p.STR + ((size_t)((b * 4 + h) * 16 + n)) * 65536;
        ret_qs_half<0>(o, qf, R0, st, tid, fr, fq);
        ret_qs_half<1>(o, qf, R0, st, tid, fr, fq); }
    const float rsc = exp2f((float)(i + 1) * lg2);
    float s1 = 0.f;
#pragma unroll
    for (int nt = 0; nt < 16; ++nt) { o[nt] = o[nt] * rsc; s1 += (o[nt][0] + o[nt][1]) + (o[nt][2] + o[nt][3]); }
    s1 += __shfl_xor(s1, 16); s1 += __shfl_xor(s1, 32);
    const float mu = s1 * (1.f / 256.f);
    float s2 = 0.f;
#pragma unroll
    for (int nt = 0; nt < 16; ++nt) { o[nt] = o[nt] - mu; s2 += (o[nt][0] * o[nt][0] + o[nt][1] * o[nt][1]) + (o[nt][2] * o[nt][2] + o[nt][3] * o[nt][3]); }
    s2 += __shfl_xor(s2, 16); s2 += __shfl_xor(s2, 32);
    const float rs = rsqrtf(s2 * (1.f / 256.f) + EPS);
#pragma unroll
    for (int nt = 0; nt < 16; ++nt) { const int col = h * 256 + nt * 16 + fq * 4; const f32x4 g = *(const f32x4*)(gn_g + col); const u32x2 gw = *(const u32x2*)(p.PRG + (size_t)row * 1024 + col);
        const f32x4 gate = {bflo(gw.x), bfhi(gw.x), bflo(gw.y), bfhi(gw.y)};
        st_bf4(p.MIX + (size_t)row * D + col, o[nt] * rs * g * gate); if ((nt & 3) == 3) __builtin_amdgcn_sched_barrier(0); }
    __syncthreads();
}

__device__ __forceinline__ void hg_out_unit(const MixPtrs& p, const float* gn_g, LAS unsigned char* lds, int unit) {
    const int tid = threadIdx.x + opaque0(), lane = tid & 63, w = __builtin_amdgcn_readfirstlane(tid >> 6), fr = lane & 15, fq = lane >> 4;
    const int c = unit & 31, h = (unit >> 5) & 7, b = unit >> 8;
    const int r0 = b * 2048 + c * 64, rt = w & 3, dh = w >> 2, i = 16 * rt + fr, row = r0 + i;
    LAS bf16_t* K2 = (LAS bf16_t*)lds;
    LAS bf16_t* VT = (LAS bf16_t*)(lds + 17408);
    LAS bf16_t* ST = (LAS bf16_t*)(lds + 35840);
    LAS bf16_t* AT = (LAS bf16_t*)(lds + 70656) + dh * 64 * 72;
    LAS float* SSQ = (LAS float*)(lds + 89088);
    bf16x8 q1f[4], q2f[4];
#pragma unroll
    for (int ks = 0; ks < 4; ++ks) { const size_t go = (size_t)row * 1024 + h * 128 + ks * 32 + fq * 8, gm = (size_t)(r0 + 31) * 1024 + h * 128 + ks * 32 + fq * 8;
        const u32x4 v = *(const u32x4*)(p.PHQ + go);
        const f32x4 b0 = *(const f32x4*)(p.PB + go), b1 = *(const f32x4*)(p.PB + go + 4), m0 = *(const f32x4*)(p.PB + gm), m1 = *(const f32x4*)(p.PB + gm + 4);
        const float x[8] = {bflo(v.x), bfhi(v.x), bflo(v.y), bfhi(v.y), bflo(v.z), bfhi(v.z), bflo(v.w), bfhi(v.w)};
        u32x4 a, bq;
        a.x = pkbf(x[0] * __expf(b0[0]), x[1] * __expf(b0[1])); a.y = pkbf(x[2] * __expf(b0[2]), x[3] * __expf(b0[3]));
        a.z = pkbf(x[4] * __expf(b1[0]), x[5] * __expf(b1[1])); a.w = pkbf(x[6] * __expf(b1[2]), x[7] * __expf(b1[3]));
        bq.x = pkbf(x[0] * __expf(b0[0] - m0[0]), x[1] * __expf(b0[1] - m0[1])); bq.y = pkbf(x[2] * __expf(b0[2] - m0[2]), x[3] * __expf(b0[3] - m0[3]));
        bq.z = pkbf(x[4] * __expf(b1[0] - m1[0]), x[5] * __expf(b1[1] - m1[1])); bq.w = pkbf(x[6] * __expf(b1[2] - m1[2]), x[7] * __expf(b1[3] - m1[3]));
        q1f[ks] = __builtin_bit_cast(bf16x8, a); q2f[ks] = __builtin_bit_cast(bf16x8, bq); }
    for (int id = tid; id < 64 * 16; id += 512) { const int j = id >> 4, cc = id & 15;
        const size_t go = (size_t)(r0 + j) * 1024 + h * 128 + cc * 8, gm = (size_t)(r0 + 31) * 1024 + h * 128 + cc * 8;
        const u32x4 v = *(const u32x4*)(p.PHK + go);
        const f32x4 b0 = *(const f32x4*)(p.PB + go), b1 = *(const f32x4*)(p.PB + go + 4), m0 = *(const f32x4*)(p.PB + gm), m1 = *(const f32x4*)(p.PB + gm + 4);
        u32x4 o;
        o.x = pkbf(bflo(v.x) * __expf(m0[0] - b0[0]), bfhi(v.x) * __expf(m0[1] - b0[1])); o.y = pkbf(bflo(v.y) * __expf(m0[2] - b0[2]), bfhi(v.y) * __expf(m0[3] - b0[3]));
        o.z = pkbf(bflo(v.z) * __expf(m1[0] - b1[0]), bfhi(v.z) * __expf(m1[1] - b1[1])); o.w = pkbf(bflo(v.w) * __expf(m1[2] - b1[2]), bfhi(v.w) * __expf(m1[3] - b1[3]));
        *(LAS u32x4*)(K2 + j * 136 + cc * 8) = o; }
    for (int id = tid; id < 64 * 16; id += 512) { const int t = id & 63, cc = id >> 6;
        const u32x4 v = *(const u32x4*)(p.PHV + (size_t)(r0 + t) * 1024 + h * 128 + cc * 8);
        LAS bf16_t* d = VT + (cc * 8) * 72 + t;
        d[0 * 72] = (bf16_t)v.x; d[1 * 72] = (bf16_t)(v.x >> 16); d[2 * 72] = (bf16_t)v.y; d[3 * 72] = (bf16_t)(v.y >> 16);
        d[4 * 72] = (bf16_t)v.z; d[5 * 72] = (bf16_t)(v.z >> 16); d[6 * 72] = (bf16_t)v.w; d[7 * 72] = (bf16_t)(v.w >> 16); }
    if (c > 0) { const bf16_t* st = p.STH + ((size_t)((b * 8 + h) * 32 + c)) * 16384;
        for (int id = tid; id < 128 * 16; id += 512) { const int rr = id >> 4, cc = id & 15; *(LAS u32x4*)(ST + rr * 136 + cc * 8) = __builtin_nontemporal_load((const u32x4*)(st + (size_t)rr * 128 + cc * 8)); } }
    __syncthreads();
    {   f32x4 att[4];
#pragma unroll
        for (int nt = 0; nt < 4; ++nt) att[nt] = (f32x4){0.f, 0.f, 0.f, 0.f};
#pragma unroll
        for (int ks = 0; ks < 4; ++ks)
#pragma unroll
            for (int nt = 0; nt < 4; ++nt) { const bf16x8 bfr = *(const LAS bf16x8*)(K2 + (nt * 16 + fr) * 136 + ks * 32 + fq * 8); att[nt] = MFMA16(bfr, q2f[ks], att[nt]); }
#pragma unroll
        for (int nt = 0; nt < 4; ++nt) { f32x4 a;
#pragma unroll
            for (int jj = 0; jj < 4; ++jj) { const int j = nt * 16 + fq * 4 + jj; a[jj] = (j <= i) ? att[nt][jj] : 0.f; }
            u32x2 wv; wv.x = pkbf(a[0], a[1]); wv.y = pkbf(a[2], a[3]); *(LAS u32x2*)(AT + i * 72 + nt * 16 + fq * 4) = wv; } }
    __syncthreads();
    f32x4 o[4];
#pragma unroll
    for (int nt = 0; nt < 4; ++nt) o[nt] = (f32x4){0.f, 0.f, 0.f, 0.f};
#pragma unroll
    for (int ks = 0; ks < 2; ++ks) { const bf16x8 af = *(const LAS bf16x8*)(AT + i * 72 + ks * 32 + fq * 8);
#pragma unroll
        for (int nt = 0; nt < 4; ++nt) { const bf16x8 bfr = *(const LAS bf16x8*)(VT + (dh * 64 + nt * 16 + fr) * 72 + ks * 32 + fq * 8); o[nt] = MFMA16(bfr, af, o[nt]); } }
    if (c > 0) {
#pragma unroll
        for (int ks = 0; ks < 4; ++ks)
#pragma unroll
            for (int nt = 0; nt < 4; ++nt) { const bf16x8 bfr = *(const LAS bf16x8*)(ST + (dh * 64 + nt * 16 + fr) * 136 + ks * 32 + fq * 8); o[nt] = MFMA16(bfr, q1f[ks], o[nt]); } }
    float s2 = 0.f;
#pragma unroll
    for (int nt = 0; nt < 4; ++nt) s2 += (o[nt][0] * o[nt][0] + o[nt][1] * o[nt][1]) + (o[nt][2] * o[nt][2] + o[nt][3] * o[nt][3]);
    s2 += __shfl_xor(s2, 16); s2 += __shfl_xor(s2, 32);
    if (fq == 0) SSQ[dh * 64 + i] = s2;
    __syncthreads();
    const float rs = rsqrtf((SSQ[i] + SSQ[64 + i]) * (1.f / 128.f) + EPS);
#pragma unroll
    for (int nt = 0; nt < 4; ++nt) { const int col = h * 128 + dh * 64 + nt * 16 + fq * 4; const f32x4 g = *(const f32x4*)(gn_g + col); const u32x2 gw = *(const u32x2*)(p.PGG + (size_t)row * 1024 + col);
        const f32x4 gate = {bflo(gw.x), bfhi(gw.x), bflo(gw.y), bfhi(gw.y)};
        st_bf4(p.MIX + (size_t)row * D + 1024 + col, o[nt] * rs * g * gate); }
    __syncthreads();
}

struct S5Par { float ar, ai; float bbr[16], bbi[16]; };
__device__ __forceinline__ void s5_setup(const Args& A, int g, int pp, S5Par& P) {
    const float dt = expf(A.in[15][g]); const float lr = A.in[13][g * 64 + pp], li = A.in[14][g * 64 + pp];
    const float mag = expf(lr * dt);
    const double th = (double)li * (double)dt; const double kk = rint(th * 0.15915494309189535); const float r = (float)(th - kk * 6.283185307179586);
    const float ar = mag * cosf(r), ai = mag * sinf(r);
    const float den = lr * lr + li * li; const float cr = ((ar - 1.f) * lr + ai * li) / den, ci = (ai * lr - (ar - 1.f) * li) / den;
    P.ar = ar; P.ai = ai;
    const float* br = A.in[16] + (size_t)(g * 64 + pp) * 16; const float* bi = A.in[17] + (size_t)(g * 64 + pp) * 16;
#pragma unroll
    for (int q = 0; q < 4; ++q) { const f32x4 r4 = *(const f32x4*)(br + 4 * q), i4 = *(const f32x4*)(bi + 4 * q);
#pragma unroll
        for (int j = 0; j < 4; ++j) { P.bbr[4 * q + j] = cr * r4[j] - ci * i4[j]; P.bbi[4 * q + j] = cr * i4[j] + ci * r4[j]; } }
}
__device__ __forceinline__ f32x4 ldn(const float* p, float rs, const f32x4& gn) { return *(const f32x4*)p * rs * gn; }
template <bool FULL> __device__ __forceinline__ void s5_tile(const float* HF, const float* SSQ, const f32x4& gA, const f32x4& gB, const f32x4& gC, bf16_t* Z, int g, int t0, int tnext, int lane, int fr, int fq, LAS float* BU, LAS bf16_t* HSb,
                                                            const bf16x8 (&bbf)[8], const bf16x8 (&cf)[4], float ar, float ai, float& hr, float& hi, const f32x4& dsk, f32x4& pu0, f32x4& pu1, f32x4& pu4) {
    const f32x4 u0 = pu0, u1 = pu1, u4 = pu4;
    {   const float* up = HF + (size_t)(tnext + fr) * D + g * 16;
        const float rs = rsqrtf(SSQ[tnext + fr] * (1.f / D) + EPS);
        pu0 = ldn(up + 8 * (fq & 1), rs, gA); pu1 = ldn(up + 8 * (fq & 1) + 4, rs, gB); if (FULL) pu4 = ldn(up + 4 * fq, rs, gC); }
    u32x4 uw; uw.x = pkbf(u0[0], u0[1]); uw.y = pkbf(u0[2], u0[3]); uw.z = pkbf(u1[0], u1[1]); uw.w = pkbf(u1[2], u1[3]);
    const bf16x8 uf = __builtin_bit_cast(bf16x8, uw);
#pragma unroll
    for (int nt = 0; nt < 8; ++nt) { const f32x4 z4 = {0.f, 0.f, 0.f, 0.f}; const f32x4 acc = MFMA16(bbf[nt], uf, z4); *(LAS f32x4*)(BU + fr * 144 + nt * 16 + 4 * fq) = acc; }
    LDS_WAIT();
    f32x2 bu[16];
#pragma unroll
    for (int t = 0; t < 16; ++t) bu[t] = *(const LAS f32x2*)(BU + t * 144 + 2 * lane);
#pragma unroll
    for (int t = 0; t < 16; ++t) { const float nr = ar * hr - ai * hi + bu[t].x, ni = ar * hi + ai * hr + bu[t].y; hr = nr; hi = ni;
        if (FULL) *(LAS unsigned*)(HSb + t * 144 + 2 * lane) = pkbf(hr, hi); }
    LDS_WAIT();
    if (FULL) {
        f32x4 y = {0.f, 0.f, 0.f, 0.f};
#pragma unroll
        for (int ks = 0; ks < 4; ++ks) { const bf16x8 af = *(const LAS bf16x8*)(HSb + fr * 144 + ks * 32 + fq * 8); y = MFMA16(cf[ks], af, y); }
        f32x4 z;
#pragma unroll
        for (int e = 0; e < 4; ++e) z[e] = gelu_tanh(y[e] + dsk[e] * u4[e]);
        st_bf4(Z + (size_t)(t0 + fr) * D + g * 16 + 4 * fq, z);
        LDS_WAIT();
    }
}
__device__ __forceinline__ void s5_prompt_unit(const Args& A, const float* HF, const float* SSQ, bf16_t* Z, LAS unsigned char* lds, int unit) {
    const int tid = threadIdx.x + opaque0(), lane = tid & 63, w = __builtin_amdgcn_readfirstlane(tid >> 6), fr = lane & 15, fq = lane >> 4;
    const int g = unit & 127, b = unit >> 7;
    LAS float* BU = (LAS float*)(lds + w * 13824);
    LAS bf16_t* HSb = (LAS bf16_t*)(lds + w * 13824 + 9216);
    LAS float* BT = (LAS float*)(lds + 110592);
    LAS f32x2* CAR = (LAS f32x2*)(lds + 110592 + 8192);
    float ar, ai;
    {   S5Par P; s5_setup(A, g, lane, P); ar = P.ar; ai = P.ai;
        if (w == 0) {
#pragma unroll
            for (int q = 0; q < 4; ++q) { *(LAS f32x4*)(BT + (2 * lane) * 16 + 4 * q) = (f32x4){P.bbr[4 * q], P.bbr[4 * q + 1], P.bbr[4 * q + 2], P.bbr[4 * q + 3]};
                *(LAS f32x4*)(BT + (2 * lane + 1) * 16 + 4 * q) = (f32x4){P.bbi[4 * q], P.bbi[4 * q + 1], P.bbi[4 * q + 2], P.bbi[4 * q + 3]}; } } }
    __syncthreads();
    bf16x8 bbf[8], cf[4];
#pragma unroll
    for (int nt = 0; nt < 8; ++nt) { const LAS float* src = BT + (nt * 16 + fr) * 16 + 8 * (fq & 1); const f32x4 x0 = *(const LAS f32x4*)src, x1 = *(const LAS f32x4*)(src + 4);
        float v[8] = {x0[0], x0[1], x0[2], x0[3], x1[0], x1[1], x1[2], x1[3]};
        if (fq >= 2) {
#pragma unroll
            for (int e = 0; e < 8; ++e) v[e] = v[e] - __uint_as_float(pkbf(v[e], 0.f) << 16); }
        u32x4 o; o.x = pkbf(v[0], v[1]); o.y = pkbf(v[2], v[3]); o.z = pkbf(v[4], v[5]); o.w = pkbf(v[6], v[7]);
        bbf[nt] = __builtin_bit_cast(bf16x8, o); }
#pragma unroll
    for (int ks = 0; ks < 4; ++ks) { const size_t co = (size_t)(g * 16 + fr) * 64 + ks * 16 + fq * 4; const f32x4 cre = *(const f32x4*)(A.in[18] + co), cim = *(const f32x4*)(A.in[19] + co);
        u32x4 o; o.x = pkbf(cre[0], -cim[0]); o.y = pkbf(cre[1], -cim[1]); o.z = pkbf(cre[2], -cim[2]); o.w = pkbf(cre[3], -cim[3]);
        cf[ks] = __builtin_bit_cast(bf16x8, o); }
    const f32x4 dsk = *(const f32x4*)(A.in[20] + g * 16 + 4 * fq);
    const int rowb = b * 2048 + w * 256;
    float hr = 0.f, hi = 0.f;
    f32x4 pu0, pu1, pu4 = {0.f, 0.f, 0.f, 0.f};
    const float* gnp = A.in[12] + g * 16; const f32x4 gA = *(const f32x4*)(gnp + 8 * (fq & 1)), gB = *(const f32x4*)(gnp + 8 * (fq & 1) + 4), gC = *(const f32x4*)(gnp + 4 * fq);
    const float rs0 = rsqrtf(SSQ[rowb + fr] * (1.f / D) + EPS);
    {   const float* up = HF + (size_t)(rowb + fr) * D + g * 16; pu0 = ldn(up + 8 * (fq & 1), rs0, gA); pu1 = ldn(up + 8 * (fq & 1) + 4, rs0, gB); }
    for (int tile = 0; tile < 16; ++tile) s5_tile<false>(HF, SSQ, gA, gB, gC, Z, g, rowb + tile * 16, rowb + (tile < 15 ? tile + 1 : 0) * 16, lane, fr, fq, BU, HSb, bbf, cf, ar, ai, hr, hi, dsk, pu0, pu1, pu4);
    pu4 = ldn(HF + (size_t)(rowb + fr) * D + g * 16 + 4 * fq, rs0, gC);
    { f32x2 e; e.x = hr; e.y = hi; CAR[w * 64 + lane] = e; }
    __syncthreads();
    float pr = ar, pi = ai;
#pragma unroll
    for (int s = 0; s < 8; ++s) { const float t = pr * pr - pi * pi; pi = 2.f * pr * pi; pr = t; }
    hr = 0.f; hi = 0.f;
    for (int v = 0; v < w; ++v) { const f32x2 e = CAR[v * 64 + lane]; const float nr = pr * hr - pi * hi + e.x, ni = pr * hi + pi * hr + e.y; hr = nr; hi = ni; }
    for (int tile = 0; tile < 16; ++tile) s5_tile<true>(HF, SSQ, gA, gB, gC, Z, g, rowb + tile * 16, rowb + (tile < 15 ? tile + 1 : 15) * 16, lane, fr, fq, BU, HSb, bbf, cf, ar, ai, hr, hi, dsk, pu0, pu1, pu4);
    if (w == 7) { A.out[O_S5RP + (size_t)(b * 128 + g) * 64 + lane] = hr; A.out[O_S5IP + (size_t)(b * 128 + g) * 64 + lane] = hi; }
    __syncthreads();
}
__device__ __forceinline__ void s5_sample_unit(const Args& A, const float* HF, const float* SSQ, bf16_t* Z, LAS unsigned char* lds, int gq) {
    const int g = gq & 127, bs0 = (gq >> 7) * 64;
    const int tid = threadIdx.x, lane = tid & 63, w = __builtin_amdgcn_readfirstlane(tid >> 6);
    LAS f32x2* HS = (LAS f32x2*)lds + w * 64;
    LAS f32x2* CT = (LAS f32x2*)(lds + 4096);
    S5Par P; s5_setup(A, g, lane, P);
    for (int id = tid; id < 1024; id += 512) { const int c = id >> 6, pp = id & 63; f32x2 v; v.x = A.in[18][(size_t)(g * 16 + c) * 64 + pp]; v.y = A.in[19][(size_t)(g * 16 + c) * 64 + pp]; CT[pp * 16 + c] = v; }
    __syncthreads();
    for (int bs = bs0 + w; bs < bs0 + 64; bs += 8) {
        const float* up = HF + (size_t)(TP + bs) * D + g * 16; const float rs = rsqrtf(SSQ[TP + bs] * (1.f / D) + EPS); const float* gnp = A.in[12] + g * 16;
        const size_t so = (size_t)(bs * 128 + g) * 64 + lane;
        const float h0r = A.in[4][so], h0i = A.in[5][so];
        float br = 0.f, bi = 0.f;
#pragma unroll
        for (int q = 0; q < 4; ++q) { const f32x4 u4 = *(const f32x4*)(up + 4 * q) * rs * *(const f32x4*)(gnp + 4 * q);
#pragma unroll
            for (int e = 0; e < 4; ++e) { br += P.bbr[4 * q + e] * u4[e]; bi += P.bbi[4 * q + e] * u4[e]; } }
        const float hr = P.ar * h0r - P.ai * h0i + br, hi = P.ar * h0i + P.ai * h0r + bi;
        A.out[O_S5RS + so] = hr; A.out[O_S5IS + so] = hi;
        f32x2 hv; hv.x = hr; hv.y = hi; HS[lane] = hv;
        LDS_WAIT();
        const int c = lane & 15;
        float y = 0.f;
#pragma unroll 8
        for (int pp = 0; pp < 64; ++pp) { const f32x2 h2 = HS[pp]; const f32x2 cc = CT[pp * 16 + c]; y += cc.x * h2.x - cc.y * h2.y; }
        const float z = gelu_tanh(y + A.in[20][g * 16 + c] * (up[c] * rs * gnp[c]));
        if (lane < 16) Z[(size_t)(TP + bs) * D + g * 16 + c] = (bf16_t)(pkbf(z, 0.f) & 0xffffu);
        LDS_WAIT();
    }
    __syncthreads();
}

__global__ void __launch_bounds__(512) fwd_kernel(Args A) {
    extern __shared__ __attribute__((aligned(16))) unsigned char lds_raw[];
    LAS unsigned char* lds = (LAS unsigned char*)lds_raw;
    cg::grid_group grid = cg::this_grid();
    const int tid = threadIdx.x, lane = tid & 63, wave = __builtin_amdgcn_readfirstlane(tid >> 6);
    const int G = gridDim.x, bid = blockIdx.x, gw = bid * 8 + wave, NGW = G * 8;
    unsigned char* ws = A.ws;
    bf16_t* WIN = (bf16_t*)(ws + WS_WIN); bf16_t* WOUT = (bf16_t*)(ws + WS_WOUT); bf16_t* WGLU = (bf16_t*)(ws + WS_WGLU);
    bf16_t* WGU0 = (bf16_t*)(ws + WS_WGU0); bf16_t* WGU1 = (bf16_t*)(ws + WS_WGU1); bf16_t* WDN0 = (bf16_t*)(ws + WS_WDN0); bf16_t* WDN1 = (bf16_t*)(ws + WS_WDN1);
    float* XRES = (float*)(ws + WS_XRES); bf16_t* H = (bf16_t*)(ws + WS_H); bf16_t* PROJ = (bf16_t*)(ws + WS_PROJ); float* PB = (float*)(ws + WS_PROJ + 8 * PSZ);
    bf16_t* ACT = (bf16_t*)(ws + WS_PROJ); float* HF = (float*)(ws + WS_PROJ);
    float* RCOS = (float*)(ws + WS_COS); float* RSIN = (float*)(ws + WS_SIN); float* SSQ0 = (float*)(ws + WS_SSQ); float* SSQ1 = SSQ0 + MP; float* SSQ2 = SSQ0 + 2 * MP; unsigned* WQ = (unsigned*)(SSQ0 + 3 * MP); bf16_t* XB = (bf16_t*)(ws + WS_XB); float* PART = (float*)(ws + WS_PART);
    MixPtrs mp; mp.PQ = PROJ; mp.PK = PROJ + PSZ / 2; mp.PV = PROJ + 2 * (PSZ / 2); mp.PRG = PROJ + 3 * (PSZ / 2); mp.PHQ = PROJ + 4 * (PSZ / 2); mp.PHK = PROJ + 5 * (PSZ / 2);
    mp.PHV = PROJ + 6 * (PSZ / 2); mp.PGG = PROJ + 7 * (PSZ / 2); mp.PB = PB; mp.STR = (bf16_t*)(ws + WS_STR); mp.STH = (bf16_t*)(ws + WS_STH); mp.MIX = H;
    const int lo = A.ph_lo, hi = A.ph_hi;
    LAS float* cscr = (LAS float*)(lds + wave * 8448);
#define CONV_SETUP(nunits) const int cfirst = (nunits) % G; const bool cdo = bid >= cfirst; const int cgw = (bid - cfirst) * 8 + wave, cngw = (G - cfirst) * 8
#ifndef PHMASK
#define PHMASK 0x7fff
#endif
#define IN(k) (((PHMASK >> (k)) & 1) && lo <= (k) && (k) < hi)
#define SEAM(k) do { if (IN(k) && IN((k) + 1)) grid.sync(); } while (0)
#ifndef REPMASK
#define REPMASK 0
#endif
#define REPN(k) (((REPMASK >> (k)) & 1) ? 2 : 1)
#define PH(k) for (int rep_ = 0; rep_ < REPN(k); ++rep_, (rep_ < REPN(k) ? grid.sync() : (void)0)) if (IN(k))

#ifdef EXTRASYNC
    for (int es = 0; es < EXTRASYNC; ++es) grid.sync();
#endif
    PH(0) {
        LAS float* scr = (LAS float*)(lds + wave * 8448);
        prep_matrix(A.in[7], D, 8192, WIN, 0, 0, scr, gw, NGW, lane);
        for (int idx = bid * 512 + tid; idx < 2049 * 128; idx += G * 512) { const int pidx = idx >> 7, i = idx & 127;
            double inv = 1.0, pw = 0.9305720409296989;
#pragma unroll
            for (int k = 0; k < 7; ++k) { if ((i >> k) & 1) inv *= pw; pw *= pw; }
            const double ang = (pidx < 2048 ? (double)pidx : 16384.0) * inv; const double kk = rint(ang * 0.15915494309189535);
            const float r = (float)((ang - kk * 6.283185307179586) - kk * 2.4492935982947064e-16);
            RCOS[idx] = cosf(r); RSIN[idx] = sinf(r); }
        rms_rows<false>(A.in[0], A.in[1], A.in[6], H, gw, NGW, lane);
        for (int idx = bid * 512 + tid; idx < 3 * MP + 64; idx += G * 512) SSQ0[idx] = 0.f;
    }
    SEAM(0);
    PH(1) {
        pg8::Gemm g{H, WIN, MP, 8192, D}; pg8::StaticOrder S; S.init(MP, 8192, G, bid, D);
        EpiIn E{PROJ, PB, RCOS, RSIN, A.in[9]};
        pg8::gemm_phase<EpiIn, pg8::StaticOrder, true, true>(lds, g, S, E);
        {   CONV_SETUP(33 * 32);
            if (cdo) { prep_matrix(A.in[11], D, D, WOUT, 0, 0, cscr, cgw, cngw, lane);
                prep_matrix(A.in[24], D, FF, WGU0, 1, 0, cscr, cgw, cngw, lane, A.in[23]); } }
    }
    SEAM(1);
    PH(2) {
#ifndef REPSUB
#define REPSUB 0
#endif
        for (int u = bid; u < 96; u += G) { if (u >= 32) ret_scan_unit(mp, A.out + O_RETP, lds, u - 32); else hg_scan_unit(mp, A.out + O_HGP, lds, u); }
        for (;;) {
            LAS int* slot = (LAS int*)(lds + 16384);
            if (tid == 0) *slot = (int)__hip_atomic_fetch_add(WQ, 1u, __ATOMIC_RELAXED, __HIP_MEMORY_SCOPE_AGENT);
            __syncthreads();
            const int u = __builtin_amdgcn_readfirstlane(*slot);
            if (u >= 512 + 1024) break;
            if (u < 512) sample_unit<true>(mp, A.in[2], A.out + O_RETS, A.in[8], lds, u);
            else sample_unit<false>(mp, A.in[3], A.out + O_HGS, A.in[10], lds, u - 512);
        }
    }
    SEAM(2);
    PH(3) {
        for (int u = bid; u < 256 + 1024; u += G) {

#ifndef NO_RET_OUT
            if (u < 256) ret_out_unit(mp, A.in[8], lds, u);
#endif
#ifndef NO_HG_OUT
            if (u >= 256) hg_out_unit(mp, A.in[10], lds, u - 256);
#endif

        }
    }
    SEAM(3);
    PH(4) {
        pg8::Gemm g{H, WOUT, MP, D, D}; pg8::StaticOrder S; S.init(MP, D, G, bid, D);
        EpiRes<0, false, true> E{XRES, A.in[0], A.in[1], XB, SSQ0};
        pg8::gemm_phase<EpiRes<0, false, true>, pg8::StaticOrder, true, true>(lds, g, S, E);
        {   CONV_SETUP(33 * 8);
            if (cdo) { prep_matrix(A.in[25], D, FF, WGU0, 1, 1, cscr, cgw, cngw, lane, A.in[23]);
                prep_matrix(A.in[26], FF, D, WDN0, 0, 0, cscr, cgw, cngw, lane); } }
    }
    SEAM(4);
    PH(6) { pg8::Gemm g{XB, WGU0, MP, 2 * FF, D}; pg8::StaticOrder S; S.init(MP, 2 * FF, G, bid, D); EpiGU E{ACT, SSQ0}; pg8::gemm_phase<EpiGU, pg8::StaticOrder, true, true>(lds, g, S, E);
        {   CONV_SETUP(33 * 44); if (cdo) { prep_matrix(A.in[21], D, D, WGLU, 1, 0, cscr, cgw, cngw, lane); prep_matrix(A.in[22], D, D, WGLU, 1, 1, cscr, cgw, cngw, lane); } } }
    SEAM(6);
    PH(7) { pg8::Gemm g{ACT, WDN0, MP, D, FF};
#if SPLITK
        SplitOrder S; S.init(D, FF, SPLITK, G, bid); EpiRes<1, true, true> E{XRES, nullptr, nullptr, nullptr, SSQ2}; EpiMux<EpiRes<1, true, true>> EM{E, PART, D}; pg8::gemm_phase<EpiMux<EpiRes<1, true, true>>, SplitOrder, true, true>(lds, g, S, EM);
        grid.sync(); reduce_partials<SPLITK>(PART, D, G, bid); grid.sync(); finalize_sample(E, PART, D, 1, G, bid);
#else
        pg8::StaticOrder S; S.init(MP, D, G, bid, FF); EpiRes<1, false, false> E{XRES, nullptr, nullptr, nullptr, nullptr}; pg8::gemm_phase<EpiRes<1, false, false>, pg8::StaticOrder, true, true>(lds, g, S, E);
#endif
        }
    SEAM(7);
    PH(9) {
        for (int u = bid; u < 512 + 256; u += G) { if (u < 512) s5_prompt_unit(A, XRES, SSQ2, H, lds, u); else s5_sample_unit(A, XRES, SSQ2, H, lds, u - 512); }
    }
    SEAM(9);
    PH(10) { pg8::Gemm g{H, WGLU, MP, 2 * D, D}; pg8::StaticOrder S; S.init(MP, 2 * D, G, bid, D); EpiRes<2, false, true> E{XRES, nullptr, nullptr, XB, SSQ1}; pg8::gemm_phase<EpiRes<2, false, true>, pg8::StaticOrder, true, true>(lds, g, S, E);
        {   CONV_SETUP(33 * 16);
            if (cdo) { prep_matrix(A.in[24] + (size_t)D * FF, D, FF, WGU1, 1, 0, cscr, cgw, cngw, lane, A.in[23] + D);
                prep_matrix(A.in[25] + (size_t)D * FF, D, FF, WGU1, 1, 1, cscr, cgw, cngw, lane, A.in[23] + D); } } }
    SEAM(10);
    PH(12) { pg8::Gemm g{XB, WGU1, MP, 2 * FF, D}; pg8::StaticOrder S; S.init(MP, 2 * FF, G, bid, D); EpiGU E{ACT, SSQ1}; pg8::gemm_phase<EpiGU, pg8::StaticOrder, true, true>(lds, g, S, E);
        {   CONV_SETUP(33 * 44); if (cdo) prep_matrix(A.in[26] + (size_t)D * FF, FF, D, WDN1, 0, 0, cscr, cgw, cngw, lane); } }
    SEAM(12);
    PH(13) { pg8::Gemm g{ACT, WDN1, MP, D, FF};
#if SPLITK
        SplitOrder S; S.init(D, FF, SPLITK, G, bid); EpiRes<1, true, false> E{XRES, nullptr, nullptr, nullptr, nullptr}; EpiMux<EpiRes<1, true, false>> EM{E, PART, D}; pg8::gemm_phase<EpiMux<EpiRes<1, true, false>>, SplitOrder, true, true>(lds, g, S, EM);
        grid.sync(); reduce_partials<SPLITK>(PART, D, G, bid); grid.sync(); finalize_sample(E, PART, D, 1, G, bid);
#else
        pg8::StaticOrder S; S.init(MP, D, G, bid, FF); EpiRes<1, false, false> E{XRES, nullptr, nullptr, nullptr, nullptr}; pg8::gemm_phase<EpiRes<1, false, false>, pg8::StaticOrder, true, true>(lds, g, S, E);
#endif
        }
    SEAM(13);
    PH(14) rms_rows<true>(XRES, nullptr, A.in[27], A.out + O_Y, gw, NGW, lane);
#undef IN
#undef SEAM
}

extern "C" void kernel_launch(void* const* d_in, const int* in_sizes, int n_in, void* d_out, int out_size, void* d_ws, size_t ws_size, hipStream_t stream) {
    static int grid = 0;
    if (grid == 0) {
        if (n_in != 28 || (size_t)out_size != O_END || ws_size < WS_END) { fprintf(stderr, "kernel_launch: unexpected shapes n_in %d out %d ws %zu\n", n_in, out_size, ws_size); grid = -1; return; }
        int dev = 0, cus = 0, per_cu = 0;
        (void)hipGetDevice(&dev); (void)hipDeviceGetAttribute(&cus, hipDeviceAttributeMultiprocessorCount, dev);
        if (hipFuncSetAttribute((const void*)fwd_kernel, hipFuncAttributeMaxDynamicSharedMemorySize, LDS_BYTES) != hipSuccess) { fprintf(stderr, "kernel_launch: hipFuncSetAttribute failed\n"); grid = -1; return; }
        if (hipOccupancyMaxActiveBlocksPerMultiprocessor(&per_cu, (const void*)fwd_kernel, 512, LDS_BYTES) != hipSuccess || per_cu < 1) { fprintf(stderr, "kernel_launch: occupancy query says %d\n", per_cu); per_cu = 1; }
        (void)hipGetLastError();
        grid = cus;
        fprintf(stderr, "kernel_launch: grid %d (cus %d, per_cu %d)\n", grid, cus, per_cu);
    }
    if (grid < 0) return;
    Args a{};
    for (int i = 0; i < 28; ++i) a.in[i] = (const float*)d_in[i];
    a.out = (float*)d_out; a.ws = (unsigned char*)d_ws;
#if ONE_LAUNCH
    a.ph_lo = 0; a.ph_hi = NPH;
    void* args[] = {&a};
    hipError_t e = hipLaunchCooperativeKernel((const void*)fwd_kernel, dim3(grid), dim3(512), args, LDS_BYTES, stream);
    if (e != hipSuccess) fprintf(stderr, "kernel_launch: cooperative launch failed: %s\n", hipGetErrorString(e));
#else
    for (int ph = 0; ph < NPH; ++ph) { a.ph_lo = ph; a.ph_hi = ph + 1; hipLaunchKernelGGL(fwd_kernel, dim3(grid), dim3(512), LDS_BYTES, stream, a); }
#endif
}
```

```cpp
#include <hip/hip_runtime.h>
#include <hip/hip_cooperative_groups.h>
#include <cstdio>
#include <cstdint>
namespace cg = cooperative_groups;
namespace pg8 {
#define PG8_LAS __attribute__((address_space(3)))
typedef unsigned short bf16_t;
typedef short bf16x8 __attribute__((ext_vector_type(8)));
typedef float f32x4 __attribute__((ext_vector_type(4)));
typedef unsigned u32x4 __attribute__((ext_vector_type(4)));
constexpr int BM = 256, BK = 64, HALF = 128, HTB = HALF * BK * 2  , STAGE_BYTES = 8 * HTB, NXCD = 8, WGM = 8;

__host__ __device__ __forceinline__ int lds_byte(int r, int c) { const int st = (r >> 4) * 2 + (c >> 5), rr = r & 15, cc = c & 31, ob = rr * 64 + cc * 2; return st * 1024 + (ob ^ (((ob >> 9) & 1) << 5)); }
__host__ __device__ __forceinline__ void stage_rc(int b, int& R, int& C) { const int st = b / 1024, sb = b % 1024, swz = sb ^ (((sb >> 9) & 1) << 5); R = (st >> 1) * 16 + swz / 64; C = (st & 1) * 32 + (swz % 64) / 2; }
__host__ __device__ __forceinline__ int perm32(int rho) { const int n = rho >> 4, i = rho & 15; return 8 * (i >> 2) + 4 * n + (i & 3); }

struct Unit { int pm, pn, kt0, nkt; };
struct Gemm { const bf16_t* A; const bf16_t* Bt; int M, N, K; };

struct StaticOrder {
    int nM, nN, nwg, G, c, nkt;
    __host__ __device__ __forceinline__ void init(int M, int N, int G_, int c_, int K) { nM = M / BM; nN = N / BM; nwg = nM * nN; G = G_; c = c_; nkt = K / BK; }
    __host__ __device__ __forceinline__ bool next(int i, Unit& u) const {
        const long L = (long)i * G + c; if (L >= nwg) return false;
        int wgid = (int)L; { const int q = nwg / NXCD, r = nwg % NXCD, xcd = wgid % NXCD, off = wgid / NXCD; wgid = (xcd < r ? xcd * (q + 1) : r * (q + 1) + (xcd - r) * q) + off; }
        const int nig = WGM * nN, gid = wgid / nig, fm = gid * WGM, gsz = (nM - fm) < WGM ? (nM - fm) : WGM;
        u.pm = fm + ((wgid % nig) % gsz); u.pn = (wgid % nig) / gsz; u.kt0 = 0; u.nkt = nkt; return true;
    }
    __device__ __forceinline__ void a_ready(const Unit&) const {}
    __device__ __forceinline__ void done(const Unit&) const {}
};
__device__ __forceinline__ unsigned cvt_pk_bf16(float lo, float hi) { unsigned r; asm volatile("v_cvt_pk_bf16_f32 %0, %1, %2" : "=v"(r) : "v"(lo), "v"(hi)); return r; }
typedef float f32x2 __attribute__((ext_vector_type(2)));
template <class Epi, class Sched, bool ALIGN_EPI = false, bool SP2 = false>
__device__ __forceinline__ void gemm_phase(PG8_LAS unsigned char* lds, const Gemm g, const Sched& S, const Epi& E) {
    const int tid = threadIdx.x, wid = __builtin_amdgcn_readfirstlane(tid >> 6), lane = tid & 63, wr = wid >> 2, wc = wid & 3, fr = lane & 15, fq = lane >> 4;
    const int K = g.K;
    unsigned voffA[2], voffB[2];
#pragma unroll
    for (int i = 0; i < 2; ++i) { int R, C; stage_rc(tid * 16 + i * 8192, R, C); const int Rb = Epi::PERM ? ((R & ~31) + perm32(R & 31)) : R;
        voffA[i] = (unsigned)(R * K + C) * 2u; voffB[i] = (unsigned)(Rb * K + C) * 2u; }
    const size_t kstep = (size_t)(BK * 2);
    const size_t hstep = (size_t)HALF * K * 2;
    const size_t tstep = 2 * hstep;
    const unsigned ldsw = (unsigned)wid * 1024u;
    const int aoff = lds_byte(wr * 64 + fr, fq * 8), boff = lds_byte(wc * 32 + fr, fq * 8);
#define PG8_SA(b, h) (((b) * 2 + (h)) * HTB)
#define PG8_SB(b, h) ((4 + (b) * 2 + (h)) * HTB)
#define PG8_STAGE(bufoff, gbase, voff) do { _Pragma("unroll") for (int _i = 0; _i < 2; ++_i) \
        __builtin_amdgcn_global_load_lds((const unsigned*)((const char*)(gbase) + (voff)[_i]), (PG8_LAS unsigned*)(lds + (bufoff) + ldsw + _i * 8192), 16, 0, 0); } while (0)
#define PG8_LDA(dst, b, h) do { _Pragma("unroll") for (int m = 0; m < 4; ++m) _Pragma("unroll") for (int k = 0; k < 2; ++k) dst[m][k] = *(const PG8_LAS bf16x8*)(lds + PG8_SA(b, h) + aoff + m * 2048 + k * 1024); } while (0)
#define PG8_LDB(dst, b, h) do { _Pragma("unroll") for (int n = 0; n < 2; ++n) _Pragma("unroll") for (int k = 0; k < 2; ++k) dst[n][k] = *(const PG8_LAS bf16x8*)(lds + PG8_SB(b, h) + boff + n * 2048 + k * 1024); } while (0)
#define PG8_MMA(ai, bj, At, Bt) do { __builtin_amdgcn_s_setprio(1); _Pragma("unroll") for (int m = 0; m < 4; ++m) _Pragma("unroll") for (int n = 0; n < 2; ++n) _Pragma("unroll") for (int k = 0; k < 2; ++k) \
        acc[ai][bj][m][n] = __builtin_amdgcn_mfma_f32_16x16x32_bf16(Bt[n][k], At[m][k], acc[ai][bj][m][n], 0, 0, 0); __builtin_amdgcn_s_setprio(0); } while (0)
#define PG8_WAIT_V(n) asm volatile("s_waitcnt vmcnt(" #n ")" ::: "memory")
#define PG8_WAIT_L(n) asm volatile("s_waitcnt lgkmcnt(" #n ")" ::: "memory")
#define PG8_BAR __builtin_amdgcn_s_barrier()
#define PG8_SCHED __builtin_amdgcn_sched_barrier(0)
    Unit cur, nxt; int ui = 0;
    if (!S.next(0, cur)) return;
    f32x4 acc[2][2][4][2];
#pragma unroll
    for (int a = 0; a < 2; ++a)
#pragma unroll
        for (int b = 0; b < 2; ++b)
#pragma unroll
            for (int m = 0; m < 4; ++m)
#pragma unroll
                for (int n = 0; n < 2; ++n) acc[a][b][m][n] = (f32x4){0.f, 0.f, 0.f, 0.f};
    bf16x8 At[4][2], B0[2][2], B1[2][2];
    const char* cA = (const char*)g.A + (size_t)cur.pm * tstep + (size_t)cur.kt0 * kstep; const char* cB = (const char*)g.Bt + (size_t)cur.pn * tstep + (size_t)cur.kt0 * kstep;
    S.a_ready(cur);
    if constexpr (SP2) {
        PG8_STAGE(PG8_SB(0, 0), cB, voffB); PG8_STAGE(PG8_SB(0, 1), cB + hstep, voffB); PG8_STAGE(PG8_SA(0, 0), cA, voffA); PG8_STAGE(PG8_SA(0, 1), cA + hstep, voffA);
        if (wr == 1) PG8_BAR;
        PG8_WAIT_V(2); PG8_BAR;
        PG8_STAGE(PG8_SB(1, 0), cB + kstep, voffB); PG8_STAGE(PG8_SA(1, 0), cA + kstep, voffA); PG8_STAGE(PG8_SB(1, 1), cB + hstep + kstep, voffB);
        PG8_WAIT_V(6); PG8_BAR;
    } else {
        PG8_STAGE(PG8_SB(0, 0), cB, voffB); PG8_STAGE(PG8_SA(0, 0), cA, voffA); PG8_STAGE(PG8_SB(0, 1), cB + hstep, voffB); PG8_STAGE(PG8_SA(0, 1), cA + hstep, voffA);
        if (wr == 1) PG8_BAR;
        PG8_WAIT_V(4); PG8_BAR;
        PG8_STAGE(PG8_SB(1, 0), cB + kstep, voffB); PG8_STAGE(PG8_SA(1, 0), cA + kstep, voffA); PG8_STAGE(PG8_SB(1, 1), cB + hstep + kstep, voffB);
        PG8_WAIT_V(6); PG8_BAR;
    }
    for (;;) {
        const bool has_next = S.next(ui + 1, nxt);
        const char* nA = has_next ? (const char*)g.A + (size_t)nxt.pm * tstep + (size_t)nxt.kt0 * kstep : cA; const char* nB = has_next ? (const char*)g.Bt + (size_t)nxt.pn * tstep + (size_t)nxt.kt0 * kstep : cB;
        const int nt = cur.nkt;
        for (int t = 0; t < nt; t += 2) {
            const bool last = (t == nt - 2);
            const char* a1 = cA + (size_t)(t + 1) * kstep;
            const char* a2 = last ? nA : cA + (size_t)(t + 2) * kstep; const char* b2 = last ? nB : cB + (size_t)(t + 2) * kstep;
            const char* a3 = a2 + kstep; const char* b3 = b2 + kstep;
            if (last && has_next) S.a_ready(nxt);
            if constexpr (SP2) {
            PG8_LDB(B0, 0, 0); PG8_LDB(B1, 0, 1); PG8_SCHED; PG8_LDA(At, 0, 0); PG8_STAGE(PG8_SA(1, 1), a1 + hstep, voffA);
            PG8_WAIT_V(8); PG8_WAIT_L(0); PG8_BAR; PG8_MMA(0, 0, At, B0); PG8_MMA(0, 1, At, B1); PG8_BAR; PG8_SCHED;
            PG8_LDA(At, 0, 1); PG8_STAGE(PG8_SB(0, 0), b2, voffB); PG8_STAGE(PG8_SB(0, 1), b2 + hstep, voffB); PG8_STAGE(PG8_SA(0, 0), a2, voffA);
            PG8_WAIT_V(8); PG8_WAIT_L(0); PG8_BAR; PG8_MMA(1, 0, At, B0); PG8_MMA(1, 1, At, B1); PG8_BAR; PG8_SCHED;
            PG8_LDB(B0, 1, 0); PG8_LDB(B1, 1, 1); PG8_SCHED; PG8_LDA(At, 1, 0); PG8_STAGE(PG8_SA(0, 1), a2 + hstep, voffA);
            PG8_WAIT_V(8); PG8_WAIT_L(0); PG8_BAR; PG8_MMA(0, 0, At, B0); PG8_MMA(0, 1, At, B1); PG8_BAR; PG8_SCHED;
            PG8_LDA(At, 1, 1); PG8_STAGE(PG8_SB(1, 0), b3, voffB); PG8_STAGE(PG8_SB(1, 1), b3 + hstep, voffB); PG8_STAGE(PG8_SA(1, 0), a3, voffA);
            PG8_WAIT_V(8); PG8_WAIT_L(0); PG8_BAR; PG8_MMA(1, 0, At, B0); PG8_MMA(1, 1, At, B1); PG8_BAR; PG8_SCHED;
            } else {
            PG8_LDB(B0, 0, 0); PG8_SCHED; PG8_LDA(At, 0, 0); PG8_STAGE(PG8_SA(1, 1), a1 + hstep, voffA);
            PG8_WAIT_L(8); PG8_BAR; PG8_WAIT_L(0); PG8_MMA(0, 0, At, B0); PG8_BAR; PG8_SCHED;
            PG8_LDB(B1, 0, 1); PG8_STAGE(PG8_SB(0, 0), b2, voffB);
            PG8_BAR; PG8_WAIT_L(0); PG8_MMA(0, 1, At, B1); PG8_BAR;
            PG8_LDA(At, 0, 1); PG8_STAGE(PG8_SA(0, 0), a2, voffA);
            PG8_BAR; PG8_WAIT_L(0); PG8_MMA(1, 0, At, B0); PG8_BAR; PG8_SCHED;
            PG8_STAGE(PG8_SB(0, 1), b2 + hstep, voffB);
            PG8_WAIT_V(6); PG8_BAR; PG8_MMA(1, 1, At, B1); PG8_BAR;
            PG8_LDB(B0, 1, 0); PG8_SCHED; PG8_LDA(At, 1, 0); PG8_STAGE(PG8_SA(0, 1), a2 + hstep, voffA);
            PG8_WAIT_L(8); PG8_BAR; PG8_WAIT_L(0); PG8_MMA(0, 0, At, B0); PG8_BAR; PG8_SCHED;
            PG8_LDB(B1, 1, 1); PG8_STAGE(PG8_SB(1, 0), b3, voffB);
            PG8_BAR; PG8_WAIT_L(0); PG8_MMA(0, 1, At, B1); PG8_BAR;
            PG8_LDA(At, 1, 1); PG8_STAGE(PG8_SA(1, 0), a3, voffA);
            PG8_BAR; PG8_WAIT_L(0); PG8_MMA(1, 0, At, B0); PG8_BAR; PG8_SCHED;
            PG8_STAGE(PG8_SB(1, 1), b3 + hstep, voffB);
            PG8_WAIT_V(6); PG8_BAR; PG8_MMA(1, 1, At, B1); PG8_BAR;
            }
        }
        if constexpr (ALIGN_EPI) { if (wr == 0) PG8_BAR; }
        if constexpr (!Epi::AFTER_DRAIN) { E(acc, cur, wr, wc, fr, fq); S.done(cur); }
        if (!has_next) break;
#pragma unroll
        for (int a = 0; a < 2; ++a)
#pragma unroll
            for (int b = 0; b < 2; ++b)
#pragma unroll
                for (int m = 0; m < 4; ++m)
#pragma unroll
                    for (int n = 0; n < 2; ++n) acc[a][b][m][n] = (f32x4){0.f, 0.f, 0.f, 0.f};
        cur = nxt; cA = nA; cB = nB; ++ui;
        if constexpr (ALIGN_EPI) { if (wr == 1) PG8_BAR; }
    }
    PG8_WAIT_V(0);
    if constexpr (!ALIGN_EPI) { if (wr == 0) PG8_BAR; }
    PG8_BAR;
    if constexpr (Epi::AFTER_DRAIN) { E.fused(acc, cur, wr, wc, fr, fq, lds, wid, lane); S.done(cur); }
#undef PG8_SA
#undef PG8_SB
#undef PG8_STAGE
#undef PG8_LDA
#undef PG8_LDB
#undef PG8_MMA
#undef PG8_WAIT_V
#undef PG8_WAIT_L
#undef PG8_BAR
#undef PG8_SCHED
}
}

#define LAS __attribute__((address_space(3)))
typedef pg8::bf16_t bf16_t;
typedef pg8::bf16x8 bf16x8;
typedef pg8::f32x4 f32x4;
typedef pg8::u32x4 u32x4;
typedef unsigned u32x2 __attribute__((ext_vector_type(2)));
typedef float f32x2 __attribute__((ext_vector_type(2)));

#ifndef SPLITK
#define SPLITK 22
#endif
#ifndef ONE_LAUNCH
#define ONE_LAUNCH 1
#endif

constexpr int D = 2048, TP = 8192, MR = 8320, MP = 8448, FF = 5632, NPH = 15;
constexpr float EPS = 1e-6f;
constexpr size_t MiB = (size_t)1 << 20;
constexpr size_t WS_COS = 0, WS_SIN = 1536 * 1024, WS_WIN = 4 * MiB, WS_WOUT = 36 * MiB, WS_WGLU = 44 * MiB, WS_WGU0 = 60 * MiB, WS_WGU1 = 104 * MiB,
                 WS_WDN0 = 148 * MiB, WS_WDN1 = 170 * MiB, WS_XRES = 192 * MiB, WS_H = 258 * MiB, WS_PROJ = 291 * MiB, PSZ = (size_t)MP * 1024 * 2,
                 WS_SSQ = 3 * MiB, WS_XB = 456 * MiB, WS_STR = 456 * MiB, WS_STH = 488 * MiB, WS_PART = 520 * MiB, WS_END = 552 * MiB;
constexpr size_t O_Y = 0, O_RETP = 17039360, O_RETS = 18087936, O_HGP = 51642368, O_HGS = 52166656, O_S5RP = 68943872, O_S5IP = 68976640, O_S5RS = 69009408,
                 O_S5IS = 70057984, O_END = 71106560;
constexpr int LDS_BYTES = 147456;

struct Args { const float* in[28]; float* out; unsigned char* ws; int ph_lo, ph_hi; };

#define LDS_WAIT() asm volatile("s_waitcnt lgkmcnt(0)" ::: "memory")
#define LDS_BARRIER() do { asm volatile("s_waitcnt lgkmcnt(0)" ::: "memory"); __builtin_amdgcn_s_barrier(); asm volatile("" ::: "memory"); } while (0)
#define MFMA16(a, b, c) __builtin_amdgcn_mfma_f32_16x16x32_bf16((a), (b), (c), 0, 0, 0)

__device__ __forceinline__ unsigned pkbf(float lo, float hi) { return pg8::cvt_pk_bf16(lo, hi); }
__device__ __forceinline__ float bflo(unsigned w) { return __uint_as_float(w << 16); }
__device__ __forceinline__ float bfhi(unsigned w) { return __uint_as_float(w & 0xffff0000u); }
__device__ __forceinline__ float bf2f(bf16_t b) { return __uint_as_float(((unsigned)b) << 16); }
__device__ __forceinline__ void st_bf4(bf16_t* p, f32x4 v) { u32x2 w; w.x = pkbf(v[0], v[1]); w.y = pkbf(v[2], v[3]); *(u32x2*)p = w; }
__device__ __forceinline__ float sigm(float x) { return __builtin_amdgcn_rcpf(1.f + __expf(-x)); }
__device__ __forceinline__ float silu(float x) { return x * sigm(x); }
__device__ __forceinline__ int opaque0() { int z; asm volatile("v_mov_b32 %0, 0" : "=v"(z)); return z; }
__device__ __forceinline__ float wave_sum(float v) {
#pragma unroll
    for (int o = 1; o < 64; o <<= 1) v += __shfl_xor(v, o);
    return v;
}
__device__ __forceinline__ float gelu_tanh(float x) {
    const float u = 0.7978845608028654f * (x + 0.044715f * x * x * x);
    const float e = __expf(2.f * u);
    const float th = 1.f - 2.f * __builtin_amdgcn_rcpf(e + 1.f);
    return 0.5f * x * (1.f + th);
}

struct EpiIn {
    static constexpr bool PERM = true, AFTER_DRAIN = false;
    bf16_t* P; float* PB; const float* rcos; const float* rsin; const float* hg_lb;
    __device__ __forceinline__ void operator()(const f32x4 (&acc)[2][2][4][2], const pg8::Unit& u, int wr, int wc, int fr, int fq) const {
        const int sec = u.pn >> 2, hd = u.pn & 3;
        const int rowb = u.pm * 256 + wr * 64 + fr;
        if (sec < 2) {
            bf16_t* O = P + (size_t)sec * (PSZ / 2); const float sc = sec == 0 ? 1.f : 0.0625f;
#pragma unroll
            for (int ai = 0; ai < 2; ++ai)
#pragma unroll
                for (int m = 0; m < 4; ++m) { const int row = rowb + ai * 128 + m * 16;
                    if (row < MR) { const int pidx = row < TP ? (row & 2047) : 2048;
                        const int i0 = wc * 32 + fq * 8; u32x4 w1, w2;
#pragma unroll
                        for (int n = 0; n < 2; ++n) {
                            const f32x4 c = *(const f32x4*)(rcos + pidx * 128 + i0 + 4 * n), s = *(const f32x4*)(rsin + pidx * 128 + i0 + 4 * n);
                            const f32x4 x1 = acc[ai][0][m][n], x2 = acc[ai][1][m][n];
                            const f32x4 o1 = (x1 * c - x2 * s) * sc, o2 = (x1 * s + x2 * c) * sc;
                            if (n == 0) { w1.x = pkbf(o1[0], o1[1]); w1.y = pkbf(o1[2], o1[3]); w2.x = pkbf(o2[0], o2[1]); w2.y = pkbf(o2[2], o2[3]); }
                            else { w1.z = pkbf(o1[0], o1[1]); w1.w = pkbf(o1[2], o1[3]); w2.z = pkbf(o2[0], o2[1]); w2.w = pkbf(o2[2], o2[3]); } }
                        bf16_t* rp = O + (size_t)row * 1024 + hd * 256 + i0;
                        *(u32x4*)rp = w1; *(u32x4*)(rp + 128) = w2; } }
        } else if (sec == 5) {
            bf16_t* OK_ = P + (size_t)5 * (PSZ / 2);
#pragma unroll
            for (int bj = 0; bj < 2; ++bj)
#pragma unroll
                for (int n = 0; n < 2; ++n) { const int col = hd * 256 + bj * 128 + wc * 32 + fq * 8 + n * 4;
                    const f32x4 a0 = *(const f32x4*)(hg_lb + col), a1 = *(const f32x4*)(hg_lb + 1024 + col), a2 = *(const f32x4*)(hg_lb + 2048 + col);
                    f32x4 lb;
#pragma unroll
                    for (int j = 0; j < 4; ++j) { const float mx = fmaxf(a0[j], fmaxf(a1[j], a2[j])); const float e0 = __expf(a0[j] - mx), e1 = __expf(a1[j] - mx), e2 = __expf(a2[j] - mx); lb[j] = e0 / (e0 + e1 + e2); }
#pragma unroll
                    for (int ai = 0; ai < 2; ++ai) { f32x4 lf[4];
#pragma unroll
                        for (int m = 0; m < 4; ++m) { const int row = rowb + ai * 128 + m * 16; f32x4 hk;
#pragma unroll
                            for (int j = 0; j < 4; ++j) { const float g = acc[ai][bj][m][n][j]; const float e = __expf(-g); const float sg = __builtin_amdgcn_rcpf(1.f + e);
                                const float f = lb[j] + (1.f - lb[j]) * sg; lf[m][j] = __logf(f); hk[j] = (1.f - lb[j]) * (e * sg); }
                            if (row < MR) st_bf4(OK_ + (size_t)row * 1024 + col, hk); }
                        if (u.pm < 32) {
                            f32x4 off = {0.f, 0.f, 0.f, 0.f};
#pragma unroll
                            for (int m = 0; m < 4; ++m) { f32x4 s = lf[m];
#pragma unroll
                                for (int d = 1; d < 16; d <<= 1) {
#pragma unroll
                                    for (int j = 0; j < 4; ++j) { const float t = __shfl_up(s[j], d, 16); if (fr >= d) s[j] += t; } }
                                s = s + off;
#pragma unroll
                                for (int j = 0; j < 4; ++j) off[j] = __shfl(s[j], 15, 16);
                                lf[m] = s; }
                        }
#pragma unroll
                        for (int m = 0; m < 4; ++m) { const int row = rowb + ai * 128 + m * 16; if (row < MR) *(f32x4*)(PB + (size_t)row * 1024 + col) = lf[m]; } } }
        } else {
            bf16_t* O = P + (size_t)sec * (PSZ / 2); const bool act = (sec == 3) | (sec == 4) | (sec == 7);
#pragma unroll
            for (int ai = 0; ai < 2; ++ai)
#pragma unroll
                for (int m = 0; m < 4; ++m) { const int row = rowb + ai * 128 + m * 16;
                    if (row < MR) {
#pragma unroll
                        for (int bj = 0; bj < 2; ++bj) { const int col = hd * 256 + bj * 128 + wc * 32 + fq * 8; f32x4 v0 = acc[ai][bj][m][0], v1 = acc[ai][bj][m][1];
                            if (act) {
#pragma unroll
                                for (int j = 0; j < 4; ++j) { v0[j] = silu(v0[j]); v1[j] = silu(v1[j]); } }
                            u32x4 wv; wv.x = pkbf(v0[0], v0[1]); wv.y = pkbf(v0[2], v0[3]); wv.z = pkbf(v1[0], v1[1]); wv.w = pkbf(v1[2], v1[3]);
                            *(u32x4*)(O + (size_t)row * 1024 + col) = wv; } } }
        }
    }
};
template <int MODE, bool SPLIT, bool FUSE> struct EpiRes {
    static constexpr bool PERM = false, AFTER_DRAIN = false;
    float* X; const float* xp; const float* xs; bf16_t* XB; float* SSQ;
    __device__ __forceinline__ void operator()(const f32x4 (&acc)[2][2][4][2], const pg8::Unit& u, int wr, int wc, int fr, int fq) const {
        const int rowb = u.pm * 256 + wr * 64 + fr;
        const bool at = false;
#pragma unroll
        for (int ai = 0; ai < 2; ++ai)
#pragma unroll
            for (int m = 0; m < 4; ++m) { const int row = rowb + ai * 128 + m * 16; float ss = 0.f;
                if (row < MR) { float* xr = X + (size_t)row * D;
                    if (MODE == 2) {
#pragma unroll
                        for (int n = 0; n < 2; ++n) { const int col = u.pn * 128 + wc * 32 + n * 16 + fq * 4; const f32x4 a = acc[ai][0][m][n], b = acc[ai][1][m][n]; f32x4 r = *(const f32x4*)(xr + col);
#pragma unroll
                            for (int j = 0; j < 4; ++j) r[j] += a[j] * sigm(b[j]);
                            *(f32x4*)(xr + col) = r;
                            if (FUSE) { if (XB) st_bf4(XB + (size_t)row * D + col, r); ss += (r[0] * r[0] + r[1] * r[1]) + (r[2] * r[2] + r[3] * r[3]); } }
                    } else if (at) {
#pragma unroll
                        for (int bj = 0; bj < 2; ++bj)
#pragma unroll
                            for (int n = 0; n < 2; ++n) { const int col = u.pn * 256 + bj * 128 + wc * 32 + n * 16 + fq * 4;
#pragma unroll
                                for (int j = 0; j < 4; ++j) __hip_atomic_fetch_add(xr + col + j, acc[ai][bj][m][n][j], __ATOMIC_RELAXED, __HIP_MEMORY_SCOPE_AGENT); }
                    } else { const float* br = MODE == 0 ? (row < TP ? xp + (size_t)row * D : xs + (size_t)(row - TP) * D) : xr;
#pragma unroll
                        for (int bj = 0; bj < 2; ++bj)
#pragma unroll
                            for (int n = 0; n < 2; ++n) { const int col = u.pn * 256 + bj * 128 + wc * 32 + n * 16 + fq * 4; const f32x4 r = *(const f32x4*)(br + col) + acc[ai][bj][m][n]; *(f32x4*)(xr + col) = r;
                                if (FUSE) { if (XB) st_bf4(XB + (size_t)row * D + col, r); ss += (r[0] * r[0] + r[1] * r[1]) + (r[2] * r[2] + r[3] * r[3]); } } } }
                if (FUSE) { ss += __shfl_xor(ss, 16); ss += __shfl_xor(ss, 32); if (fq == 0 && row < MR) __hip_atomic_fetch_add(SSQ + row, ss, __ATOMIC_RELAXED, __HIP_MEMORY_SCOPE_AGENT); } }
    }
};
struct SplitOrder {
    pg8::StaticOrder so; int nN, NS, nkt_all, G, c, nmain;
    __device__ __forceinline__ void init(int N, int K, int NS_, int G_, int c_) { so.init(TP, N, G_, c_, K); nN = N / 256; NS = NS_; nkt_all = K / 64; G = G_; c = c_; nmain = 32 * nN; }
    __device__ __forceinline__ bool next(int i, pg8::Unit& u) const {
        const long L = (long)i * G + c; const bool mn = L < nmain; const long Ls = L - nmain; if (!mn && Ls >= (long)nN * NS) return false;
        int wgid = mn ? (int)L : 0; { const int nwg = nmain, q = nwg / pg8::NXCD, r = nwg % pg8::NXCD, xcd = wgid % pg8::NXCD, off = wgid / pg8::NXCD; wgid = (xcd < r ? xcd * (q + 1) : r * (q + 1) + (xcd - r) * q) + off; }
        const int nig = pg8::WGM * nN, gid = wgid / nig, fm = gid * pg8::WGM, gsz = (32 - fm) < pg8::WGM ? (32 - fm) : pg8::WGM;
        const int pm_m = fm + ((wgid % nig) % gsz), pn_m = (wgid % nig) / gsz; const int ks = mn ? 0 : (int)(Ls / nN), sub = nkt_all / NS;
        u.pm = mn ? pm_m : 32; u.pn = mn ? pn_m : (int)(Ls % nN); u.nkt = mn ? nkt_all : sub; u.kt0 = ks * sub; return true; }
    __device__ __forceinline__ void a_ready(const pg8::Unit&) const {}
    __device__ __forceinline__ void done(const pg8::Unit&) const {}
};
template <class E> struct EpiMux {
    static constexpr bool PERM = false, AFTER_DRAIN = false;
    E e; float* PART; int N;
    __device__ __forceinline__ void operator()(const f32x4 (&acc)[2][2][4][2], const pg8::Unit& u, int wr, int wc, int fr, int fq) const {
        if (u.pm == 32) { const int ks = u.kt0 / u.nkt; float* pb = PART + ((size_t)ks * 128 + wr * 64 + fr) * N + u.pn * 256 + wc * 32 + fq * 4;
#pragma unroll
            for (int m = 0; m < 4; ++m)
#pragma unroll
                for (int bj = 0; bj < 2; ++bj)
#pragma unroll
                    for (int n = 0; n < 2; ++n) *(f32x4*)(pb + (size_t)(m * 16) * N + bj * 128 + n * 16) = acc[0][bj][m][n];
        } else e(acc, u, wr, wc, fr, fq);
    }
};
template <int NS> __device__ __forceinline__ void reduce_partials(float* PART, int N, int G, int bid) {
    const size_t slab = (size_t)128 * N; const int nv = (int)(slab / 4);
    for (int idx = bid * 512 + (int)threadIdx.x; idx < nv; idx += G * 512) { f32x4 v[NS];
#pragma unroll
        for (int ks = 0; ks < NS; ++ks) v[ks] = *(const f32x4*)(PART + (size_t)ks * slab + (size_t)idx * 4);
        f32x4 t = v[0];
#pragma unroll
        for (int ks = 1; ks < NS; ++ks) t = t + v[ks];
        *(f32x4*)(PART + (size_t)idx * 4) = t; }
}
template <class E> __device__ __forceinline__ void finalize_sample(const E& e, const float* PART, int N, int NS, int G, int bid) {
    const int tid = threadIdx.x + opaque0(), lane = tid & 63, wid = __builtin_amdgcn_readfirstlane(tid >> 6), wr = wid >> 2, wc = wid & 3, fr = lane & 15, fq = lane >> 4;
    for (int pn = bid; pn < N / 256; pn += G) {
        f32x4 acc[2][2][4][2];
#pragma unroll
        for (int a = 0; a < 2; ++a)
#pragma unroll
            for (int b = 0; b < 2; ++b)
#pragma unroll
                for (int m = 0; m < 4; ++m)
#pragma unroll
                    for (int n = 0; n < 2; ++n) acc[a][b][m][n] = (f32x4){0.f, 0.f, 0.f, 0.f};
        const float* pb = PART + ((size_t)wr * 64 + fr) * N + pn * 256 + wc * 32 + fq * 4;
#pragma unroll 1
        for (int ks = 0; ks < NS; ++ks) {
#pragma unroll
            for (int m = 0; m < 4; ++m)
#pragma unroll
                for (int bj = 0; bj < 2; ++bj)
#pragma unroll
                    for (int n = 0; n < 2; ++n) acc[0][bj][m][n] = acc[0][bj][m][n] + *(const f32x4*)(pb + ((size_t)ks * 128 + m * 16) * N + bj * 128 + n * 16); }
        pg8::Unit u; u.pm = 32; u.pn = pn; u.kt0 = 0; u.nkt = 1;
        e(acc, u, wr, wc, fr, fq);
    }
}
struct EpiGU {
    static constexpr bool PERM = true, AFTER_DRAIN = false;
    bf16_t* A; const float* SSQ;
    __device__ __forceinline__ void operator()(const f32x4 (&acc)[2][2][4][2], const pg8::Unit& u, int wr, int wc, int fr, int fq) const {
        const int rowb = u.pm * 256 + wr * 64 + fr;
        const int col = u.pn * 128 + wc * 32 + fq * 8;
#pragma unroll
        for (int ai = 0; ai < 2; ++ai)
#pragma unroll
            for (int m = 0; m < 4; ++m) { const int row = rowb + ai * 128 + m * 16;
                if (row < MR) { const float rstd = rsqrtf(SSQ[row] * (1.f / D) + EPS);
                    const f32x4 g0 = acc[ai][0][m][0] * rstd, g1 = acc[ai][0][m][1] * rstd, u0 = acc[ai][1][m][0] * rstd, u1 = acc[ai][1][m][1] * rstd; f32x4 v0, v1;
#pragma unroll
                    for (int j = 0; j < 4; ++j) { v0[j] = silu(g0[j]) * u0[j]; v1[j] = silu(g1[j]) * u1[j]; }
                    u32x4 wv; wv.x = pkbf(v0[0], v0[1]); wv.y = pkbf(v0[2], v0[3]); wv.z = pkbf(v1[0], v1[1]); wv.w = pkbf(v1[2], v1[3]);
                    __builtin_nontemporal_store(wv, (u32x4*)(A + (size_t)row * FF + col)); } }
    }
};

__device__ __forceinline__ void transpose_item(const float* W, int K, int N, bf16_t* WT, int dst_row, LAS float* scr, int k0, int n0, int lane, const float* gain) {
#pragma unroll
    for (int i = 0; i < 32; ++i) { const int kk = 2 * i + (lane >> 5); scr[kk * 33 + (lane & 31)] = __builtin_nontemporal_load(W + (size_t)(k0 + kk) * N + n0 + (lane & 31)); }
    LDS_WAIT();
    const int c = lane & 7;
    f32x4 g0 = {1.f, 1.f, 1.f, 1.f}, g1 = g0;
    if (gain) { g0 = *(const f32x4*)(gain + k0 + 8 * c); g1 = *(const f32x4*)(gain + k0 + 8 * c + 4); }
#pragma unroll
    for (int j = 0; j < 4; ++j) { const int n = (lane >> 3) + 8 * j; const LAS float* s = scr + (8 * c) * 33 + n;
        u32x4 o; o.x = pkbf(s[0 * 33] * g0[0], s[1 * 33] * g0[1]); o.y = pkbf(s[2 * 33] * g0[2], s[3 * 33] * g0[3]); o.z = pkbf(s[4 * 33] * g1[0], s[5 * 33] * g1[1]); o.w = pkbf(s[6 * 33] * g1[2], s[7 * 33] * g1[3]);
        *(u32x4*)(WT + (size_t)(dst_row + n) * K + k0 + 8 * c) = o; }
    LDS_WAIT();
}
__device__ __forceinline__ void prep_matrix(const float* W, int K, int N, bf16_t* WT, int mode, int sel, LAS float* scr, int gw, int NGW, int lane_, const float* gain = nullptr) {
    const int lane = lane_ + opaque0();
    const int nblk = N / 32, items = (K / 64) * nblk;
    for (int it = gw; it < items; it += NGW) { const int kb = it / nblk, nb = it - kb * nblk, n0 = nb * 32;
        const int dst = mode ? ((n0 >> 7) * 256 + sel * 128 + (n0 & 127)) : n0;
        transpose_item(W, K, N, WT, dst, scr, kb * 64, n0, lane, gain); }
}
template <bool OUTF> __device__ __forceinline__ void rms_rows(const float* xa, const float* xb, const float* g, void* out, int gw, int NGW, int lane) {
    for (int row = gw; row < MR; row += NGW) {
        const float* xr = (xb != nullptr && row >= TP) ? xb + (size_t)(row - TP) * D : xa + (size_t)row * D;
        f32x4 v[8]; float s = 0.f;
#pragma unroll
        for (int j = 0; j < 8; ++j) { v[j] = __builtin_nontemporal_load((const f32x4*)(xr + 4 * lane + 256 * j)); s += (v[j][0] * v[j][0] + v[j][1] * v[j][1]) + (v[j][2] * v[j][2] + v[j][3] * v[j][3]); }
        const float rstd = rsqrtf(wave_sum(s) * (1.f / D) + EPS);
#pragma unroll
        for (int j = 0; j < 8; ++j) { const f32x4 gg = *(const f32x4*)(g + 4 * lane + 256 * j); const f32x4 o = v[j] * rstd * gg;
            if (OUTF) __builtin_nontemporal_store(o, (f32x4*)((float*)out + (size_t)row * D + 4 * lane + 256 * j)); else st_bf4((bf16_t*)out + (size_t)row * D + 4 * lane + 256 * j, o); }
    }
}


struct MixPtrs { const bf16_t *PQ, *PK, *PV, *PRG, *PHQ, *PHK, *PHV, *PGG; const float* PB; bf16_t *STR, *STH, *MIX; };

__device__ __forceinline__ void ret_scan_unit(const MixPtrs& p, float* out_state, LAS unsigned char* lds, int unit) {
    const int tid = threadIdx.x + opaque0(), lane = tid & 63, w = __builtin_amdgcn_readfirstlane(tid >> 6), fr = lane & 15, fq = lane >> 4;
    const int dvs = unit & 3, h = (unit >> 2) & 3, b = unit >> 4;
    LAS bf16_t* VT = (LAS bf16_t*)lds;
    LAS bf16_t* KT = (LAS bf16_t*)(lds + 64 * 136 * 2);
    const float gamma = 1.f - exp2f(-5.f - (float)h), lg2 = log2f(gamma), cdec = exp2f(128.f * lg2);
    f32x4 acc[4][2];
#pragma unroll
    for (int a = 0; a < 4; ++a)
#pragma unroll
        for (int c = 0; c < 2; ++c) acc[a][c] = (f32x4){0.f, 0.f, 0.f, 0.f};
    u32x4 rk[8], rv[2];
#define RT_LOAD(n_) do { const int r0_ = b * 2048 + (n_) * 128; \
        _Pragma("unroll") for (int it = 0; it < 8; ++it) { const int id = tid + it * 512; rk[it] = *(const u32x4*)(p.PK + (size_t)(r0_ + (id & 127)) * 1024 + h * 256 + (id >> 7) * 8); } \
        _Pragma("unroll") for (int it = 0; it < 2; ++it) { const int id = tid + it * 512; rv[it] = *(const u32x4*)(p.PV + (size_t)(r0_ + (id & 127)) * 1024 + h * 256 + dvs * 64 + (id >> 7) * 8); } } while (0)
    RT_LOAD(0);
    const float kd = exp2f((float)(127 - (tid & 127)) * lg2);
    for (int n = 0; n < 16; ++n) {
        if (n > 0) { bf16_t* st = p.STR + ((size_t)((b * 4 + h) * 16 + n)) * 65536;
#pragma unroll
            for (int mt = 0; mt < 4; ++mt)
#pragma unroll
                for (int nt = 0; nt < 2; ++nt) st_bf4(st + (size_t)(dvs * 64 + mt * 16 + fr) * 256 + w * 32 + nt * 16 + fq * 4, acc[mt][nt]); }
        LDS_BARRIER();
#pragma unroll
        for (int it = 0; it < 8; ++it) { const int id = tid + it * 512, t = id & 127, cc = id >> 7; const u32x4 v = rk[it];
            LAS bf16_t* d = KT + (cc * 8) * 136 + t;
            const unsigned w0 = pkbf(bflo(v.x) * kd, bfhi(v.x) * kd), w1 = pkbf(bflo(v.y) * kd, bfhi(v.y) * kd), w2 = pkbf(bflo(v.z) * kd, bfhi(v.z) * kd), w3 = pkbf(bflo(v.w) * kd, bfhi(v.w) * kd);
            d[0 * 136] = (bf16_t)w0; d[1 * 136] = (bf16_t)(w0 >> 16); d[2 * 136] = (bf16_t)w1; d[3 * 136] = (bf16_t)(w1 >> 16);
            d[4 * 136] = (bf16_t)w2; d[5 * 136] = (bf16_t)(w2 >> 16); d[6 * 136] = (bf16_t)w3; d[7 * 136] = (bf16_t)(w3 >> 16); }
#pragma unroll
        for (int it = 0; it < 2; ++it) { const int id = tid + it * 512, t = id & 127, cc = id >> 7; const u32x4 v = rv[it];
            LAS bf16_t* d = VT + (cc * 8) * 136 + t;
            d[0 * 136] = (bf16_t)v.x; d[1 * 136] = (bf16_t)(v.x >> 16); d[2 * 136] = (bf16_t)v.y; d[3 * 136] = (bf16_t)(v.y >> 16);
            d[4 * 136] = (bf16_t)v.z; d[5 * 136] = (bf16_t)(v.z >> 16); d[6 * 136] = (bf16_t)v.w; d[7 * 136] = (bf16_t)(v.w >> 16); }
        if (n + 1 < 16) RT_LOAD(n + 1);
        LDS_BARRIER();
#pragma unroll
        for (int a = 0; a < 4; ++a)
#pragma unroll
            for (int c = 0; c < 2; ++c) acc[a][c] = acc[a][c] * cdec;
#pragma unroll
        for (int ks = 0; ks < 4; ++ks) { bf16x8 af[4], bfr[2];
#pragma unroll
            for (int mt = 0; mt < 4; ++mt) af[mt] = *(const LAS bf16x8*)(VT + (mt * 16 + fr) * 136 + ks * 32 + fq * 8);
#pragma unroll
            for (int nt = 0; nt < 2; ++nt) bfr[nt] = *(const LAS bf16x8*)(KT + (w * 32 + nt * 16 + fr) * 136 + ks * 32 + fq * 8);
#pragma unroll
            for (int mt = 0; mt < 4; ++mt)
#pragma unroll
                for (int nt = 0; nt < 2; ++nt) acc[mt][nt] = MFMA16(bfr[nt], af[mt], acc[mt][nt]); }
    }
#undef RT_LOAD
    float* os = out_state + (size_t)(b * 4 + h) * 65536;
#pragma unroll
    for (int mt = 0; mt < 4; ++mt)
#pragma unroll
        for (int nt = 0; nt < 2; ++nt)
#pragma unroll
            for (int j = 0; j < 4; ++j) os[(size_t)(w * 32 + nt * 16 + fq * 4 + j) * 256 + dvs * 64 + mt * 16 + fr] = acc[mt][nt][j];
    __syncthreads();
}

__device__ __forceinline__ void hg_scan_unit(const MixPtrs& p, float* out_state, LAS unsigned char* lds, int unit) {
    const int tid = threadIdx.x + opaque0(), lane = tid & 63, w = __builtin_amdgcn_readfirstlane(tid >> 6), fr = lane & 15, fq = lane >> 4;
    const int h = unit & 7, b = unit >> 3;
    LAS bf16_t* VT = (LAS bf16_t*)lds;
    LAS bf16_t* KT = (LAS bf16_t*)(lds + 128 * 72 * 2);
    f32x4 acc[8];
#pragma unroll
    for (int a = 0; a < 8; ++a) acc[a] = (f32x4){0.f, 0.f, 0.f, 0.f};
    u32x4 rk[2], rv[2]; f32x4 rb0[2], rb1[2], rl0[2], rl1[2], rbl;
#define HG_LOAD(n_) do { const int r0_ = b * 2048 + (n_) * 64; \
        _Pragma("unroll") for (int it = 0; it < 2; ++it) { const int id = tid + it * 512, t = id & 63, cc = id >> 6; \
            const size_t go = (size_t)(r0_ + t) * 1024 + h * 128 + cc * 8, gl = (size_t)(r0_ + 63) * 1024 + h * 128 + cc * 8; \
            rk[it] = *(const u32x4*)(p.PHK + go); rb0[it] = *(const f32x4*)(p.PB + go); rb1[it] = *(const f32x4*)(p.PB + go + 4); rl0[it] = *(const f32x4*)(p.PB + gl); rl1[it] = *(const f32x4*)(p.PB + gl + 4); } \
        _Pragma("unroll") for (int it = 0; it < 2; ++it) { const int id = tid + it * 512; rv[it] = *(const u32x4*)(p.PHV + (size_t)(r0_ + (id & 63)) * 1024 + h * 128 + (id >> 6) * 8); } \
        rbl = *(const f32x4*)(p.PB + (size_t)(r0_ + 63) * 1024 + h * 128 + w * 16 + fq * 4); } while (0)
    HG_LOAD(0);
    for (int n = 0; n < 32; ++n) {
        if (n > 0) { bf16_t* st = p.STH + ((size_t)((b * 8 + h) * 32 + n)) * 16384;
#pragma unroll
            for (int mt = 0; mt < 8; ++mt) st_bf4(st + (size_t)(mt * 16 + fr) * 128 + w * 16 + fq * 4, acc[mt]); }
        LDS_BARRIER();
#pragma unroll
        for (int it = 0; it < 2; ++it) { const int id = tid + it * 512, t = id & 63, cc = id >> 6;
            const u32x4 v = rk[it]; const f32x4 b0 = rb0[it], b1 = rb1[it], l0 = rl0[it], l1 = rl1[it];
            LAS bf16_t* d = KT + (cc * 8) * 72 + t;
            const unsigned w0 = pkbf(bflo(v.x) * __expf(l0[0] - b0[0]), bfhi(v.x) * __expf(l0[1] - b0[1])), w1 = pkbf(bflo(v.y) * __expf(l0[2] - b0[2]), bfhi(v.y) * __expf(l0[3] - b0[3]));
            const unsigned w2 = pkbf(bflo(v.z) * __expf(l1[0] - b1[0]), bfhi(v.z) * __expf(l1[1] - b1[1])), w3 = pkbf(bflo(v.w) * __expf(l1[2] - b1[2]), bfhi(v.w) * __expf(l1[3] - b1[3]));
            d[0 * 72] = (bf16_t)w0; d[1 * 72] = (bf16_t)(w0 >> 16); d[2 * 72] = (bf16_t)w1; d[3 * 72] = (bf16_t)(w1 >> 16);
            d[4 * 72] = (bf16_t)w2; d[5 * 72] = (bf16_t)(w2 >> 16); d[6 * 72] = (bf16_t)w3; d[7 * 72] = (bf16_t)(w3 >> 16); }
#pragma unroll
        for (int it = 0; it < 2; ++it) { const int id = tid + it * 512, t = id & 63, cc = id >> 6; const u32x4 v = rv[it];
            LAS bf16_t* d = VT + (cc * 8) * 72 + t;
            d[0 * 72] = (bf16_t)v.x; d[1 * 72] = (bf16_t)(v.x >> 16); d[2 * 72] = (bf16_t)v.y; d[3 * 72] = (bf16_t)(v.y >> 16);
            d[4 * 72] = (bf16_t)v.z; d[5 * 72] = (bf16_t)(v.z >> 16); d[6 * 72] = (bf16_t)v.w; d[7 * 72] = (bf16_t)(v.w >> 16); }
        f32x4 e4;
#pragma unroll
        for (int j = 0; j < 4; ++j) e4[j] = __expf(rbl[j]);
        if (n + 1 < 32) HG_LOAD(n + 1);
        LDS_BARRIER();
#pragma unroll
        for (int a = 0; a < 8; ++a) acc[a] = acc[a] * e4;
#pragma unroll
        for (int ks = 0; ks < 2; ++ks) { const bf16x8 bfr = *(const LAS bf16x8*)(KT + (w * 16 + fr) * 72 + ks * 32 + fq * 8);
#pragma unroll
            for (int mt = 0; mt < 8; ++mt) { const bf16x8 af = *(const LAS bf16x8*)(VT + (mt * 16 + fr) * 72 + ks * 32 + fq * 8); acc[mt] = MFMA16(bfr, af, acc[mt]); } }
    }
#undef HG_LOAD
    float* os = out_state + (size_t)(b * 8 + h) * 16384;
#pragma unroll
    for (int mt = 0; mt < 8; ++mt)
#pragma unroll
        for (int j = 0; j < 4; ++j) os[(size_t)(w * 16 + fq * 4 + j) * 128 + mt * 16 + fr] = acc[mt][j];
    __syncthreads();
}

template <bool RET> __device__ __forceinline__ void sample_unit(const MixPtrs& p, const float* s_in, float* s_out, const float* gn_g, LAS unsigned char* lds, int unit) {
    constexpr int DK = RET ? 256 : 128, NH = RET ? 4 : 8, TX = DK / 4, NTY = 512 / TX, NIT = DK / NTY;
    const int tid = threadIdx.x, tx = tid % TX, ty = tid / TX;
    const int h = unit % NH, bs = unit / NH, row = TP + bs;
    const bf16_t* q = (RET ? p.PQ : p.PHQ) + (size_t)row * 1024 + h * DK;
    const bf16_t* k = (RET ? p.PK : p.PHK) + (size_t)row * 1024 + h * DK;
    const bf16_t* v = (RET ? p.PV : p.PHV) + (size_t)row * 1024 + h * DK;
    const float* fb = p.PB + (size_t)row * 1024 + h * DK;
    const u32x2 vv = *(const u32x2*)(v + 4 * tx);
    const f32x4 v4 = {bflo(vv.x), bfhi(vv.x), bflo(vv.y), bfhi(vv.y)};
    const float gamma = 1.f - exp2f(-5.f - (float)h);
    const size_t sb = (size_t)unit * DK * DK;
    LAS f32x4* cf = (LAS f32x4*)(lds + 8192);
    if (tid < DK) { f32x4 c; c[0] = RET ? gamma : __expf(fb[tid]); c[1] = bf2f(k[tid]); c[2] = bf2f(q[tid]); c[3] = 0.f; cf[tid] = c; }
    __syncthreads();
    f32x4 o = {0.f, 0.f, 0.f, 0.f};
#pragma unroll 8
    for (int i = 0; i < NIT; ++i) { const int dk = ty + NTY * i;
        const f32x4 c = cf[dk]; const float dec = c[0], kk = c[1], qq = c[2];
        const f32x4 s = __builtin_nontemporal_load((const f32x4*)(s_in + sb + (size_t)dk * DK + 4 * tx));
        const f32x4 sn = s * dec + v4 * kk;
        __builtin_nontemporal_store(sn, (f32x4*)(s_out + sb + (size_t)dk * DK + 4 * tx));
        o = o + sn * qq; }
    LAS f32x4* red = (LAS f32x4*)lds;
    red[ty * TX + tx] = o;
    __syncthreads();
    if (tid < 64) {
        f32x4 t = {0.f, 0.f, 0.f, 0.f};
        if (tid < TX) {
#pragma unroll 4
            for (int y = 0; y < NTY; ++y) t = t + red[y * TX + tid]; }
        const int col = h * DK + 4 * tid;
        if (RET) { const float mu = wave_sum((t[0] + t[1]) + (t[2] + t[3])) * (1.f / DK); const f32x4 dlt = t - mu;
            const float var = wave_sum((dlt[0] * dlt[0] + dlt[1] * dlt[1]) + (dlt[2] * dlt[2] + dlt[3] * dlt[3])) * (1.f / DK); const float rs = rsqrtf(var + EPS);
            const f32x4 g = *(const f32x4*)(gn_g + col); const u32x2 gw = *(const u32x2*)(p.PRG + (size_t)row * 1024 + col);
            const f32x4 gate = {bflo(gw.x), bfhi(gw.x), bflo(gw.y), bfhi(gw.y)};
            st_bf4(p.MIX + (size_t)row * D + col, dlt * rs * g * gate);
        } else { const float ss = wave_sum((t[0] * t[0] + t[1] * t[1]) + (t[2] * t[2] + t[3] * t[3])) * (1.f / DK); const float rs = rsqrtf(ss + EPS);
            if (tid < TX) { const f32x4 g = *(const f32x4*)(gn_g + col); const u32x2 gw = *(const u32x2*)(p.PGG + (size_t)row * 1024 + col);
                const f32x4 gate = {bflo(gw.x), bfhi(gw.x), bflo(gw.y), bfhi(gw.y)};
                st_bf4(p.MIX + (size_t)row * D + 1024 + col, t * rs * g * gate); } }
    }
    __syncthreads();
}


template <int HALF> __device__ __forceinline__ void ret_qs_half(f32x4 (&o)[16], const bf16x8 (&qf)[8], LAS bf16_t* R0, const bf16_t* st, int tid, int fr, int fq) {
    __syncthreads();
    for (int id = tid; id < 128 * 32; id += 512) { const int rr = id >> 5, cc = id & 31; *(LAS u32x4*)(R0 + rr * 264 + cc * 8) = *(const u32x4*)(st + (size_t)(HALF * 128 + rr) * 256 + cc * 8); }
    __syncthreads();
#pragma unroll
    for (int ks = 0; ks < 8; ++ks) {
#pragma unroll
        for (int nt = 0; nt < 8; ++nt) { const bf16x8 bfr = *(const LAS bf16x8*)(R0 + (nt * 16 + fr) * 264 + ks * 32 + fq * 8); o[HALF * 8 + nt] = MFMA16(bfr, qf[ks], o[HALF * 8 + nt]); }
        __builtin_amdgcn_sched_barrier(0); }
}
__device__ __forceinline__ void ret_out_unit(const MixPtrs& p, const float* gn_g, LAS unsigned char* lds, int unit) {
    const int tid = threadIdx.x + opaque0(), lane = tid & 63, w = __builtin_amdgcn_readfirstlane(tid >> 6), fr = lane & 15, fq = lane >> 4;
    const int n = unit & 15, h = (unit >> 4) & 3, b = unit >> 6;
    const int r0 = b * 2048 + n * 128, i = 16 * w + fr, row = r0 + i;
    LAS bf16_t* R0 = (LAS bf16_t*)lds;
    LAS bf16_t* R1 = (LAS bf16_t*)(lds + 69632);
    const float gamma = 1.f - exp2f(-5.f - (float)h), lg2 = log2f(gamma);
    bf16x8 qf[8];
#pragma unroll
    for (int ks = 0; ks < 8; ++ks) qf[ks] = *(const bf16x8*)(p.PQ + (size_t)row * 1024 + h * 256 + ks * 32 + fq * 8);
    for (int id = tid; id < 128 * 32; id += 512) { const int rr = id >> 5, cc = id & 31; *(LAS u32x4*)(R0 + rr * 264 + cc * 8) = *(const u32x4*)(p.PK + (size_t)(r0 + rr) * 1024 + h * 256 + cc * 8); }
    __syncthreads();
    {   f32x4 att[8];
#pragma unroll
        for (int nt = 0; nt < 8; ++nt) att[nt] = (f32x4){0.f, 0.f, 0.f, 0.f};
#pragma unroll
        for (int ks = 0; ks < 8; ++ks) {
#pragma unroll
            for (int nt = 0; nt < 8; ++nt) { const bf16x8 bfr = *(const LAS bf16x8*)(R0 + (nt * 16 + fr) * 264 + ks * 32 + fq * 8); att[nt] = MFMA16(bfr, qf[ks], att[nt]); }
            __builtin_amdgcn_sched_barrier(0); }
#pragma unroll
        for (int nt = 0; nt < 8; ++nt) { f32x4 a;
#pragma unroll
            for (int jj = 0; jj < 4; ++jj) { const int j = nt * 16 + fq * 4 + jj; a[jj] = (j <= i) ? att[nt][jj] * exp2f(-(float)(j + 1) * lg2) : 0.f; }
            u32x2 wv; wv.x = pkbf(a[0], a[1]); wv.y = pkbf(a[2], a[3]); *(LAS u32x2*)(R1 + i * 136 + nt * 16 + fq * 4) = wv; } }
    __syncthreads();
    for (int id = tid; id < 128 * 32; id += 512) { const int t = id & 127, cc = id >> 7;
        const u32x4 v = *(const u32x4*)(p.PV + (size_t)(r0 + t) * 1024 + h * 256 + cc * 8);
        LAS bf16_t* d = R0 + (cc * 8) * 136 + t;
        d[0 * 136] = (bf16_t)v.x; d[1 * 136] = (bf16_t)(v.x >> 16); d[2 * 136] = (bf16_t)v.y; d[3 * 136] = (bf16_t)(v.y >> 16);
        d[4 * 136] = (bf16_t)v.z; d[5 * 136] = (bf16_t)(v.z >> 16); d[6 * 136] = (bf16_t)v.w; d[7 * 136] = (bf16_t)(v.w >> 16); }
    __syncthreads();
    f32x4 o[16];
#pragma unroll
    for (int nt = 0; nt < 16; ++nt) o[nt] = (f32x4){0.f, 0.f, 0.f, 0.f};
#pragma unroll
    for (int ks = 0; ks < 4; ++ks) { const bf16x8 af = *(const LAS bf16x8*)(R1 + i * 136 + ks * 32 + fq * 8);
#pragma unroll
        for (int nt = 0; nt < 16; ++nt) { const bf16x8 bfr = *(const LAS bf16x8*)(R0 + (nt * 16 + fr) * 136 + ks * 32 + fq * 8); o[nt] = MFMA16(bfr, af, o[nt]); if ((nt & 7) == 7) __builtin_amdgcn_sched_barrier(0); } }
    if (n > 0) { const bf16_t* st = p.STR + ((size_t)((b * 4 + h) * 16 + n)) * 65536;
        ret_qs_half<0>(o, qf, R0, st, tid, fr, fq);
        ret_qs_half<1>(o, qf, R0, st, tid, fr, fq); }
    const float rsc = exp2f((float)(i + 1) * lg2);
    float s1 = 0.f;
#pragma unroll
    for (int nt = 0; nt < 16; ++nt) { o[nt] = o[nt] * rsc; s1 += (o[nt][0] + o[nt][1]) + (o[nt][2] + o[nt][3]); }
    s1 += __shfl_xor(s1, 16); s1 += __shfl_xor(s1, 32);
    const float mu = s1 * (1.f / 256.f);
    float s2 = 0.f;
#pragma unroll
    for (int nt = 0; nt < 16; ++nt) { o[nt] = o[nt] - mu; s2 += (o[nt][0] * o[nt][0] + o[nt][1] * o[nt][1]) + (o[nt][2] * o[nt][2] + o[nt][3] * o[nt][3]); }
    s2 += __shfl_xor(s2, 16); s2 += __shfl_xor(s2, 32);
    const float rs = rsqrtf(s2 * (1.f / 256.f) + EPS);
#pragma unroll
    for (int nt = 0; nt < 16; ++nt) { const int col = h * 256 + nt * 16 + fq * 4; const f32x4 g = *(const f32x4*)(gn_g + col); const u32x2 gw = *(const u32x2*)(p.PRG + (size_t)row * 1024 + col);
        const f32x4 gate = {bflo(gw.x), bfhi(gw.x), bflo(gw.y), bfhi(gw.y)};
        st_bf4(p.MIX + (size_t)row * D + col, o[nt] * rs * g * gate); if ((nt & 3) == 3) __builtin_amdgcn_sched_barrier(0); }
    __syncthreads();
}

__device__ __forceinline__ void hg_out_unit(const MixPtrs& p, const float* gn_g, LAS unsigned char* lds, int unit) {
    const int tid = threadIdx.x + opaque0(), lane = tid & 63, w = __builtin_amdgcn_readfirstlane(tid >> 6), fr = lane & 15, fq = lane >> 4;
    const int c = unit & 31, h = (unit >> 5) & 7, b = unit >> 8;
    const int r0 = b * 2048 + c * 64, rt = w & 3, dh = w >> 2, i = 16 * rt + fr, row = r0 + i;
    LAS bf16_t* K2 = (LAS bf16_t*)lds;
    LAS bf16_t* VT = (LAS bf16_t*)(lds + 17408);
    LAS bf16_t* ST = (LAS bf16_t*)(lds + 35840);
    LAS bf16_t* AT = (LAS bf16_t*)(lds + 70656) + dh * 64 * 72;
    LAS float* SSQ = (LAS float*)(lds + 89088);
    bf16x8 q1f[4], q2f[4];
#pragma unroll
    for (int ks = 0; ks < 4; ++ks) { const size_t go = (size_t)row * 1024 + h * 128 + ks * 32 + fq * 8, gm = (size_t)(r0 + 31) * 1024 + h * 128 + ks * 32 + fq * 8;
        const u32x4 v = *(const u32x4*)(p.PHQ + go);
        const f32x4 b0 = *(const f32x4*)(p.PB + go), b1 = *(const f32x4*)(p.PB + go + 4), m0 = *(const f32x4*)(p.PB + gm), m1 = *(const f32x4*)(p.PB + gm + 4);
        const float x[8] = {bflo(v.x), bfhi(v.x), bflo(v.y), bfhi(v.y), bflo(v.z), bfhi(v.z), bflo(v.w), bfhi(v.w)};
        u32x4 a, bq;
        a.x = pkbf(x[0] * __expf(b0[0]), x[1] * __expf(b0[1])); a.y = pkbf(x[2] * __expf(b0[2]), x[3] * __expf(b0[3]));
        a.z = pkbf(x[4] * __expf(b1[0]), x[5] * __expf(b1[1])); a.w = pkbf(x[6] * __expf(b1[2]), x[7] * __expf(b1[3]));
        bq.x = pkbf(x[0] * __expf(b0[0] - m0[0]), x[1] * __expf(b0[1] - m0[1])); bq.y = pkbf(x[2] * __expf(b0[2] - m0[2]), x[3] * __expf(b0[3] - m0[3]));
        bq.z = pkbf(x[4] * __expf(b1[0] - m1[0]), x[5] * __expf(b1[1] - m1[1])); bq.w = pkbf(x[6] * __expf(b1[2] - m1[2]), x[7] * __expf(b1[3] - m1[3]));
        q1f[ks] = __builtin_bit_cast(bf16x8, a); q2f[ks] = __builtin_bit_cast(bf16x8, bq); }
    for (int id = tid; id < 64 * 16; id += 512) { const int j = id >> 4, cc = id & 15;
        const size_t go = (size_t)(r0 + j) * 1024 + h * 128 + cc * 8, gm = (size_t)(r0 + 31) * 1024 + h * 128 + cc * 8;
        const u32x4 v = *(const u32x4*)(p.PHK + go);
        const f32x4 b0 = *(const f32x4*)(p.PB + go), b1 = *(const f32x4*)(p.PB + go + 4), m0 = *(const f32x4*)(p.PB + gm), m1 = *(const f32x4*)(p.PB + gm + 4);
        u32x4 o;
        o.x = pkbf(bflo(v.x) * __expf(m0[0] - b0[0]), bfhi(v.x) * __expf(m0[1] - b0[1])); o.y = pkbf(bflo(v.y) * __expf(m0[2] - b0[2]), bfhi(v.y) * __expf(m0[3] - b0[3]));
        o.z = pkbf(bflo(v.z) * __expf(m1[0] - b1[0]), bfhi(v.z) * __expf(m1[1] - b1[1])); o.w = pkbf(bflo(v.w) * __expf(m1[2] - b1[2]), bfhi(v.w) * __expf(m1[3] - b1[3]));
        *(LAS u32x4*)(K2 + j * 136 + cc * 8) = o; }
    for (int id = tid; id < 64 * 16; id += 512) { const int t = id & 63, cc = id >> 6;
        const u32x4 v = *(const u32x4*)(p.PHV + (size_t)(r0 + t) * 1024 + h * 128 + cc * 8);
        LAS bf16_t* d = VT + (cc * 8) * 72 + t;
        d[0 * 72] = (bf16_t)v.x; d[1 * 72] = (bf16_t)(v.x >> 16); d[2 * 72] = (bf16_t)v.y; d[3 * 72] = (bf16_t)(v.y >> 16);
        d[4 * 72] = (bf16_t)v.z; d[5 * 72] = (bf16_t)(v.z >> 16); d[6 * 72] = (bf16_t)v.w; d[7 * 72] = (bf16_t)(v.w >> 16); }
    if (c > 0) { const bf16_t* st = p.STH + ((size_t)((b * 8 + h) * 32 + c)) * 16384;
        for (int id = tid; id < 128 * 16; id += 512) { const int rr = id >> 4, cc = id & 15; *(LAS u32x4*)(ST + rr * 136 + cc * 8) = *(const u32x4*)(st + (size_t)rr * 128 + cc * 8); } }
    __syncthreads();
    {   f32x4 att[4];
#pragma unroll
        for (int nt = 0; nt < 4; ++nt) att[nt] = (f32x4){0.f, 0.f, 0.f, 0.f};
#pragma unroll
        for (int ks = 0; ks < 4; ++ks)
#pragma unroll
            for (int nt = 0; nt < 4; ++nt) { const bf16x8 bfr = *(const LAS bf16x8*)(K2 + (nt * 16 + fr) * 136 + ks * 32 + fq * 8); att[nt] = MFMA16(bfr, q2f[ks], att[nt]); }
#pragma unroll
        for (int nt = 0; nt < 4; ++nt) { f32x4 a;
#pragma unroll
            for (int jj = 0; jj < 4; ++jj) { const int j = nt * 16 + fq * 4 + jj; a[jj] = (j <= i) ? att[nt][jj] : 0.f; }
            u32x2 wv; wv.x = pkbf(a[0], a[1]); wv.y = pkbf(a[2], a[3]); *(LAS u32x2*)(AT + i * 72 + nt * 16 + fq * 4) = wv; } }
    __syncthreads();
    f32x4 o[4];
#pragma unroll
    for (int nt = 0; nt < 4; ++nt) o[nt] = (f32x4){0.f, 0.f, 0.f, 0.f};
#pragma unroll
    for (int ks = 0; ks < 2; ++ks) { const bf16x8 af = *(const LAS bf16x8*)(AT + i * 72 + ks * 32 + fq * 8);
#pragma unroll
        for (int nt = 0; nt < 4; ++nt) { const bf16x8 bfr = *(const LAS bf16x8*)(VT + (dh * 64 + nt * 16 + fr) * 72 + ks * 32 + fq * 8); o[nt] = MFMA16(bfr, af, o[nt]); } }
    if (c > 0) {
#pragma unroll
        for (int ks = 0; ks < 4; ++ks)
#pragma unroll
            for (int nt = 0; nt < 4; ++nt) { const bf16x8 bfr = *(const LAS bf16x8*)(ST + (dh * 64 + nt * 16 + fr) * 136 + ks * 32 + fq * 8); o[nt] = MFMA16(bfr, q1f[ks], o[nt]); } }
    float s2 = 0.f;
#pragma unroll
    for (int nt = 0; nt < 4; ++nt) s2 += (o[nt][0] * o[nt][0] + o[nt][1] * o[nt][1]) + (o[nt][2] * o[nt][2] + o[nt][3] * o[nt][3]);
    s2 += __shfl_xor(s2, 16); s2 += __shfl_xor(s2, 32);
    if (fq == 0) SSQ[dh * 64 + i] = s2;
    __syncthreads();
    const float rs = rsqrtf((SSQ[i] + SSQ[64 + i]) * (1.f / 128.f) + EPS);
#pragma unroll
    for (int nt = 0; nt < 4; ++nt) { const int col = h * 128 + dh * 64 + nt * 16 + fq * 4; const f32x4 g = *(const f32x4*)(gn_g + col); const u32x2 gw = *(const u32x2*)(p.PGG + (size_t)row * 1024 + col);
        const f32x4 gate = {bflo(gw.x), bfhi(gw.x), bflo(gw.y), bfhi(gw.y)};
        st_bf4(p.MIX + (size_t)row * D + 1024 + col, o[nt] * rs * g * gate); }
    __syncthreads();
}

struct S5Par { float ar, ai; float bbr[16], bbi[16]; };
__device__ __forceinline__ void s5_setup(const Args& A, int g, int pp, S5Par& P) {
    const float dt = expf(A.in[15][g]); const float lr = A.in[13][g * 64 + pp], li = A.in[14][g * 64 + pp];
    const float mag = expf(lr * dt);
    const double th = (double)li * (double)dt; const double kk = rint(th * 0.15915494309189535); const float r = (float)(th - kk * 6.283185307179586);
    const float ar = mag * cosf(r), ai = mag * sinf(r);
    const float den = lr * lr + li * li; const float cr = ((ar - 1.f) * lr + ai * li) / den, ci = (ai * lr - (ar - 1.f) * li) / den;
    P.ar = ar; P.ai = ai;
    const float* br = A.in[16] + (size_t)(g * 64 + pp) * 16; const float* bi = A.in[17] + (size_t)(g * 64 + pp) * 16;
#pragma unroll
    for (int q = 0; q < 4; ++q) { const f32x4 r4 = *(const f32x4*)(br + 4 * q), i4 = *(const f32x4*)(bi + 4 * q);
#pragma unroll
        for (int j = 0; j < 4; ++j) { P.bbr[4 * q + j] = cr * r4[j] - ci * i4[j]; P.bbi[4 * q + j] = cr * i4[j] + ci * r4[j]; } }
}
__device__ __forceinline__ f32x4 ldn(const float* p, float rs, const f32x4& gn) { return *(const f32x4*)p * rs * gn; }
template <bool FULL> __device__ __forceinline__ void s5_tile(const float* HF, const float* SSQ, const f32x4& gA, const f32x4& gB, const f32x4& gC, bf16_t* Z, int g, int t0, int tnext, int lane, int fr, int fq, LAS float* BU, LAS bf16_t* HSb,
                                                            const bf16x8 (&bbf)[8], const bf16x8 (&cf)[4], float ar, float ai, float& hr, float& hi, const f32x4& dsk, f32x4& pu0, f32x4& pu1, f32x4& pu4) {
    const f32x4 u0 = pu0, u1 = pu1, u4 = pu4;
    {   const float* up = HF + (size_t)(tnext + fr) * D + g * 16;
        const float rs = rsqrtf(SSQ[tnext + fr] * (1.f / D) + EPS);
        pu0 = ldn(up + 8 * (fq & 1), rs, gA); pu1 = ldn(up + 8 * (fq & 1) + 4, rs, gB); if (FULL) pu4 = ldn(up + 4 * fq, rs, gC); }
    u32x4 uw; uw.x = pkbf(u0[0], u0[1]); uw.y = pkbf(u0[2], u0[3]); uw.z = pkbf(u1[0], u1[1]); uw.w = pkbf(u1[2], u1[3]);
    const bf16x8 uf = __builtin_bit_cast(bf16x8, uw);
#pragma unroll
    for (int nt = 0; nt < 8; ++nt) { const f32x4 z4 = {0.f, 0.f, 0.f, 0.f}; const f32x4 acc = MFMA16(bbf[nt], uf, z4); *(LAS f32x4*)(BU + fr * 144 + nt * 16 + 4 * fq) = acc; }
    LDS_WAIT();
    f32x2 bu[16];
#pragma unroll
    for (int t = 0; t < 16; ++t) bu[t] = *(const LAS f32x2*)(BU + t * 144 + 2 * lane);
#pragma unroll
    for (int t = 0; t < 16; ++t) { const float nr = ar * hr - ai * hi + bu[t].x, ni = ar * hi + ai * hr + bu[t].y; hr = nr; hi = ni;
        if (FULL) *(LAS unsigned*)(HSb + t * 144 + 2 * lane) = pkbf(hr, hi); }
    LDS_WAIT();
    if (FULL) {
        f32x4 y = {0.f, 0.f, 0.f, 0.f};
#pragma unroll
        for (int ks = 0; ks < 4; ++ks) { const bf16x8 af = *(const LAS bf16x8*)(HSb + fr * 144 + ks * 32 + fq * 8); y = MFMA16(cf[ks], af, y); }
        f32x4 z;
#pragma unroll
        for (int e = 0; e < 4; ++e) z[e] = gelu_tanh(y[e] + dsk[e] * u4[e]);
        st_bf4(Z + (size_t)(t0 + fr) * D + g * 16 + 4 * fq, z);
        LDS_WAIT();
    }
}
__device__ __forceinline__ void s5_prompt_unit(const Args& A, const float* HF, const float* SSQ, bf16_t* Z, LAS unsigned char* lds, int unit) {
    const int tid = threadIdx.x + opaque0(), lane = tid & 63, w = __builtin_amdgcn_readfirstlane(tid >> 6), fr = lane & 15, fq = lane >> 4;
    const int g = unit & 127, b = unit >> 7;
    LAS float* BU = (LAS float*)(lds + w * 13824);
    LAS bf16_t* HSb = (LAS bf16_t*)(lds + w * 13824 + 9216);
    LAS float* BT = (LAS float*)(lds + 110592);
    LAS f32x2* CAR = (LAS f32x2*)(lds + 110592 + 8192);
    float ar, ai;
    {   S5Par P; s5_setup(A, g, lane, P); ar = P.ar; ai = P.ai;
        if (w == 0) {
#pragma unroll
            for (int q = 0; q < 4; ++q) { *(LAS f32x4*)(BT + (2 * lane) * 16 + 4 * q) = (f32x4){P.bbr[4 * q], P.bbr[4 * q + 1], P.bbr[4 * q + 2], P.bbr[4 * q + 3]};
                *(LAS f32x4*)(BT + (2 * lane + 1) * 16 + 4 * q) = (f32x4){P.bbi[4 * q], P.bbi[4 * q + 1], P.bbi[4 * q + 2], P.bbi[4 * q + 3]}; } } }
    __syncthreads();
    bf16x8 bbf[8], cf[4];
#pragma unroll
    for (int nt = 0; nt < 8; ++nt) { const LAS float* src = BT + (nt * 16 + fr) * 16 + 8 * (fq & 1); const f32x4 x0 = *(const LAS f32x4*)src, x1 = *(const LAS f32x4*)(src + 4);
        float v[8] = {x0[0], x0[1], x0[2], x0[3], x1[0], x1[1], x1[2], x1[3]};
        if (fq >= 2) {
#pragma unroll
            for (int e = 0; e < 8; ++e) v[e] = v[e] - __uint_as_float(pkbf(v[e], 0.f) << 16); }
        u32x4 o; o.x = pkbf(v[0], v[1]); o.y = pkbf(v[2], v[3]); o.z = pkbf(v[4], v[5]); o.w = pkbf(v[6], v[7]);
        bbf[nt] = __builtin_bit_cast(bf16x8, o); }
#pragma unroll
    for (int ks = 0; ks < 4; ++ks) { const size_t co = (size_t)(g * 16 + fr) * 64 + ks * 16 + fq * 4; const f32x4 cre = *(const f32x4*)(A.in[18] + co), cim = *(const f32x4*)(A.in[19] + co);
        u32x4 o; o.x = pkbf(cre[0], -cim[0]); o.y = pkbf(cre[1], -cim[1]); o.z = pkbf(cre[2], -cim[2]); o.w = pkbf(cre[3], -cim[3]);
        cf[ks] = __builtin_bit_cast(bf16x8, o); }
    const f32x4 dsk = *(const f32x4*)(A.in[20] + g * 16 + 4 * fq);
    const int rowb = b * 2048 + w * 256;
    float hr = 0.f, hi = 0.f;
    f32x4 pu0, pu1, pu4 = {0.f, 0.f, 0.f, 0.f};
    const float* gnp = A.in[12] + g * 16; const f32x4 gA = *(const f32x4*)(gnp + 8 * (fq & 1)), gB = *(const f32x4*)(gnp + 8 * (fq & 1) + 4), gC = *(const f32x4*)(gnp + 4 * fq);
    const float rs0 = rsqrtf(SSQ[rowb + fr] * (1.f / D) + EPS);
    {   const float* up = HF + (size_t)(rowb + fr) * D + g * 16; pu0 = ldn(up + 8 * (fq & 1), rs0, gA); pu1 = ldn(up + 8 * (fq & 1) + 4, rs0, gB); }
    for (int tile = 0; tile < 16; ++tile) s5_tile<false>(HF, SSQ, gA, gB, gC, Z, g, rowb + tile * 16, rowb + (tile < 15 ? tile + 1 : 0) * 16, lane, fr, fq, BU, HSb, bbf, cf, ar, ai, hr, hi, dsk, pu0, pu1, pu4);
    pu4 = ldn(HF + (size_t)(rowb + fr) * D + g * 16 + 4 * fq, rs0, gC);
    { f32x2 e; e.x = hr; e.y = hi; CAR[w * 64 + lane] = e; }
    __syncthreads();
    float pr = ar, pi = ai;
#pragma unroll
    for (int s = 0; s < 8; ++s) { const float t = pr * pr - pi * pi; pi = 2.f * pr * pi; pr = t; }
    hr = 0.f; hi = 0.f;
    for (int v = 0; v < w; ++v) { const f32x2 e = CAR[v * 64 + lane]; const float nr = pr * hr - pi * hi + e.x, ni = pr * hi + pi * hr + e.y; hr = nr; hi = ni; }
    for (int tile = 0; tile < 16; ++tile) s5_tile<true>(HF, SSQ, gA, gB, gC, Z, g, rowb + tile * 16, rowb + (tile < 15 ? tile + 1 : 15) * 16, lane, fr, fq, BU, HSb, bbf, cf, ar, ai, hr, hi, dsk, pu0, pu1, pu4);
    if (w == 7) { A.out[O_S5RP + (size_t)(b * 128 + g) * 64 + lane] = hr; A.out[O_S5IP + (size_t)(b * 128 + g) * 64 + lane] = hi; }
    __syncthreads();
}
__device__ __forceinline__ void s5_sample_unit(const Args& A, const float* HF, const float* SSQ, bf16_t* Z, LAS unsigned char* lds, int gq) {
    const int g = gq & 127, bs0 = (gq >> 7) * 64;
    const int tid = threadIdx.x, lane = tid & 63, w = __builtin_amdgcn_readfirstlane(tid >> 6);
    LAS f32x2* HS = (LAS f32x2*)lds + w * 64;
    LAS f32x2* CT = (LAS f32x2*)(lds + 4096);
    S5Par P; s5_setup(A, g, lane, P);
    for (int id = tid; id < 1024; id += 512) { const int c = id >> 6, pp = id & 63; f32x2 v; v.x = A.in[18][(size_t)(g * 16 + c) * 64 + pp]; v.y = A.in[19][(size_t)(g * 16 + c) * 64 + pp]; CT[pp * 16 + c] = v; }
    __syncthreads();
    for (int bs = bs0 + w; bs < bs0 + 64; bs += 8) {
        const float* up = HF + (size_t)(TP + bs) * D + g * 16; const float rs = rsqrtf(SSQ[TP + bs] * (1.f / D) + EPS); const float* gnp = A.in[12] + g * 16;
        const size_t so = (size_t)(bs * 128 + g) * 64 + lane;
        const float h0r = A.in[4][so], h0i = A.in[5][so];
        float br = 0.f, bi = 0.f;
#pragma unroll
        for (int q = 0; q < 4; ++q) { const f32x4 u4 = *(const f32x4*)(up + 4 * q) * rs * *(const f32x4*)(gnp + 4 * q);
#pragma unroll
            for (int e = 0; e < 4; ++e) { br += P.bbr[4 * q + e] * u4[e]; bi += P.bbi[4 * q + e] * u4[e]; } }
        const float hr = P.ar * h0r - P.ai * h0i + br, hi = P.ar * h0i + P.ai * h0r + bi;
        A.out[O_S5RS + so] = hr; A.out[O_S5IS + so] = hi;
        f32x2 hv; hv.x = hr; hv.y = hi; HS[lane] = hv;
        LDS_WAIT();
        const int c = lane & 15;
        float y = 0.f;
#pragma unroll 8
        for (int pp = 0; pp < 64; ++pp) { const f32x2 h2 = HS[pp]; const f32x2 cc = CT[pp * 16 + c]; y += cc.x * h2.x - cc.y * h2.y; }
        const float z = gelu_tanh(y + A.in[20][g * 16 + c] * (up[c] * rs * gnp[c]));
        if (lane < 16) Z[(size_t)(TP + bs) * D + g * 16 + c] = (bf16_t)(pkbf(z, 0.f) & 0xffffu);
        LDS_WAIT();
    }
    __syncthreads();
}

__global__ void __launch_bounds__(512) fwd_kernel(Args A) {
    extern __shared__ __attribute__((aligned(16))) unsigned char lds_raw[];
    LAS unsigned char* lds = (LAS unsigned char*)lds_raw;
    cg::grid_group grid = cg::this_grid();
    const int tid = threadIdx.x, lane = tid & 63, wave = __builtin_amdgcn_readfirstlane(tid >> 6);
    const int G = gridDim.x, bid = blockIdx.x, gw = bid * 8 + wave, NGW = G * 8;
    unsigned char* ws = A.ws;
    bf16_t* WIN = (bf16_t*)(ws + WS_WIN); bf16_t* WOUT = (bf16_t*)(ws + WS_WOUT); bf16_t* WGLU = (bf16_t*)(ws + WS_WGLU);
    bf16_t* WGU0 = (bf16_t*)(ws + WS_WGU0); bf16_t* WGU1 = (bf16_t*)(ws + WS_WGU1); bf16_t* WDN0 = (bf16_t*)(ws + WS_WDN0); bf16_t* WDN1 = (bf16_t*)(ws + WS_WDN1);
    float* XRES = (float*)(ws + WS_XRES); bf16_t* H = (bf16_t*)(ws + WS_H); bf16_t* PROJ = (bf16_t*)(ws + WS_PROJ); float* PB = (float*)(ws + WS_PROJ + 8 * PSZ);
    bf16_t* ACT = (bf16_t*)(ws + WS_PROJ); float* HF = (float*)(ws + WS_PROJ);
    float* RCOS = (float*)(ws + WS_COS); float* RSIN = (float*)(ws + WS_SIN); float* SSQ0 = (float*)(ws + WS_SSQ); float* SSQ1 = SSQ0 + MP; float* SSQ2 = SSQ0 + 2 * MP; unsigned* WQ = (unsigned*)(SSQ0 + 3 * MP); bf16_t* XB = (bf16_t*)(ws + WS_XB); float* PART = (float*)(ws + WS_PART);
    MixPtrs mp; mp.PQ = PROJ; mp.PK = PROJ + PSZ / 2; mp.PV = PROJ + 2 * (PSZ / 2); mp.PRG = PROJ + 3 * (PSZ / 2); mp.PHQ = PROJ + 4 * (PSZ / 2); mp.PHK = PROJ + 5 * (PSZ / 2);
    mp.PHV = PROJ + 6 * (PSZ / 2); mp.PGG = PROJ + 7 * (PSZ / 2); mp.PB = PB; mp.STR = (bf16_t*)(ws + WS_STR); mp.STH = (bf16_t*)(ws + WS_STH); mp.MIX = H;
    const int lo = A.ph_lo, hi = A.ph_hi;
    LAS float* cscr = (LAS float*)(lds + wave * 8448);
#define CONV_SETUP(nunits) const int cfirst = (nunits) % G; const bool cdo = bid >= cfirst; const int cgw = (bid - cfirst) * 8 + wave, cngw = (G - cfirst) * 8
#ifndef PHMASK
#define PHMASK 0x7fff
#endif
#define IN(k) (((PHMASK >> (k)) & 1) && lo <= (k) && (k) < hi)
#define SEAM(k) do { if (IN(k) && IN((k) + 1)) grid.sync(); } while (0)
#ifndef REPMASK
#define REPMASK 0
#endif
#define REPN(k) (((REPMASK >> (k)) & 1) ? 2 : 1)
#define PH(k) for (int rep_ = 0; rep_ < REPN(k); ++rep_, (rep_ < REPN(k) ? grid.sync() : (void)0)) if (IN(k))

#ifdef EXTRASYNC
    for (int es = 0; es < EXTRASYNC; ++es) grid.sync();
#endif
    PH(0) {
        LAS float* scr = (LAS float*)(lds + wave * 8448);
        prep_matrix(A.in[7], D, 8192, WIN, 0, 0, scr, gw, NGW, lane);
        for (int idx = bid * 512 + tid; idx < 2049 * 128; idx += G * 512) { const int pidx = idx >> 7, i = idx & 127;
            double inv = 1.0, pw = 0.9305720409296989;
#pragma unroll
            for (int k = 0; k < 7; ++k) { if ((i >> k) & 1) inv *= pw; pw *= pw; }
            const double ang = (pidx < 2048 ? (double)pidx : 16384.0) * inv; const double kk = rint(ang * 0.15915494309189535);
            const float r = (float)((ang - kk * 6.283185307179586) - kk * 2.4492935982947064e-16);
            RCOS[idx] = cosf(r); RSIN[idx] = sinf(r); }
        rms_rows<false>(A.in[0], A.in[1], A.in[6], H, gw, NGW, lane);
        for (int idx = bid * 512 + tid; idx < 3 * MP + 64; idx += G * 512) SSQ0[idx] = 0.f;
    }
    SEAM(0);
    PH(1) {
        pg8::Gemm g{H, WIN, MP, 8192, D}; pg8::StaticOrder S; S.init(MP, 8192, G, bid, D);
        EpiIn E{PROJ, PB, RCOS, RSIN, A.in[9]};
        pg8::gemm_phase<EpiIn, pg8::StaticOrder, true, true>(lds, g, S, E);
        {   CONV_SETUP(33 * 32);
            if (cdo) { prep_matrix(A.in[11], D, D, WOUT, 0, 0, cscr, cgw, cngw, lane);
                prep_matrix(A.in[24], D, FF, WGU0, 1, 0, cscr, cgw, cngw, lane, A.in[23]); } }
    }
    SEAM(1);
    PH(2) {
#ifndef REPSUB
#define REPSUB 0
#endif
        for (int u = bid; u < 96; u += G) { if (u >= 32) ret_scan_unit(mp, A.out + O_RETP, lds, u - 32); else hg_scan_unit(mp, A.out + O_HGP, lds, u); }
        for (;;) {
            LAS int* slot = (LAS int*)(lds + 16384);
            if (tid == 0) *slot = (int)__hip_atomic_fetch_add(WQ, 1u, __ATOMIC_RELAXED, __HIP_MEMORY_SCOPE_AGENT);
            __syncthreads();
            const int u = __builtin_amdgcn_readfirstlane(*slot);
            if (u >= 512 + 1024) break;
            if (u < 512) sample_unit<true>(mp, A.in[2], A.out + O_RETS, A.in[8], lds, u);
            else sample_unit<false>(mp, A.in[3], A.out + O_HGS, A.in[10], lds, u - 512);
        }
    }
    SEAM(2);
    PH(3) {
        for (int u = bid; u < 256 + 1024; u += G) {

#ifndef NO_RET_OUT
            if (u < 256) ret_out_unit(mp, A.in[8], lds, u);
#endif
#ifndef NO_HG_OUT
            if (u >= 256) hg_out_unit(mp, A.in[10], lds, u - 256);
#endif

        }
    }
    SEAM(3);
    PH(4) {
        pg8::Gemm g{H, WOUT, MP, D, D}; pg8::StaticOrder S; S.init(MP, D, G, bid, D);
        EpiRes<0, false, true> E{XRES, A.in[0], A.in[1], XB, SSQ0};
        pg8::gemm_phase<EpiRes<0, false, true>, pg8::StaticOrder, true, true>(lds, g, S, E);
        {   CONV_SETUP(33 * 8);
            if (cdo) { prep_matrix(A.in[25], D, FF, WGU0, 1, 1, cscr, cgw, cngw, lane, A.in[23]);
                prep_matrix(A.in[26], FF, D, WDN0, 0, 0, cscr, cgw, cngw, lane); } }
    }
    SEAM(4);
    PH(6) { pg8::Gemm g{XB, WGU0, MP, 2 * FF, D}; pg8::StaticOrder S; S.init(MP, 2 * FF, G, bid, D); EpiGU E{ACT, SSQ0}; pg8::gemm_phase<EpiGU, pg8::StaticOrder, true, true>(lds, g, S, E);
        {   CONV_SETUP(33 * 44); if (cdo) { prep_matrix(A.in[21], D, D, WGLU, 1, 0, cscr, cgw, cngw, lane); prep_matrix(A.in[22], D, D, WGLU, 1, 1, cscr, cgw, cngw, lane); } } }
    SEAM(6);
    PH(7) { pg8::Gemm g{ACT, WDN0, MP, D, FF};
#if SPLITK
        SplitOrder S; S.init(D, FF, SPLITK, G, bid); EpiRes<1, true, true> E{XRES, nullptr, nullptr, nullptr, SSQ2}; EpiMux<EpiRes<1, true, true>> EM{E, PART, D}; pg8::gemm_phase<EpiMux<EpiRes<1, true, true>>, SplitOrder, true, true>(lds, g, S, EM);
        grid.sync(); reduce_partials<SPLITK>(PART, D, G, bid); grid.sync(); finalize_sample(E, PART, D, 1, G, bid);
#else
        pg8::StaticOrder S; S.init(MP, D, G, bid, FF); EpiRes<1, false, false> E{XRES, nullptr, nullptr, nullptr, nullptr}; pg8::gemm_phase<EpiRes<1, false, false>, pg8::StaticOrder, true, true>(lds, g, S, E);
#endif
        }
    SEAM(7);
    PH(9) {
        for (int u = bid; u < 512 + 256; u += G) { if (u < 512) s5_prompt_unit(A, XRES, SSQ2, H, lds, u); else s5_sample_unit(A, XRES, SSQ2, H, lds, u - 512); }
    }
    SEAM(9);
    PH(10) { pg8::Gemm g{H, WGLU, MP, 2 * D, D}; pg8::StaticOrder S; S.init(MP, 2 * D, G, bid, D); EpiRes<2, false, true> E{XRES, nullptr, nullptr, XB, SSQ1}; pg8::gemm_phase<EpiRes<2, false, true>, pg8::StaticOrder, true, true>(lds, g, S, E);
        {   CONV_SETUP(33 * 16);
            if (cdo) { prep_matrix(A.in[24] + (size_t)D * FF, D, FF, WGU1, 1, 0, cscr, cgw, cngw, lane, A.in[23] + D);
                prep_matrix(A.in[25] + (size_t)D * FF, D, FF, WGU1, 1, 1, cscr, cgw, cngw, lane, A.in[23] + D); } } }
    SEAM(10);
    PH(12) { pg8::Gemm g{XB, WGU1, MP, 2 * FF, D}; pg8::StaticOrder S; S.init(MP, 2 * FF, G, bid, D); EpiGU E{ACT, SSQ1}; pg8::gemm_phase<EpiGU, pg8::StaticOrder, true, true>(lds, g, S, E);
        {   CONV_SETUP(33 * 44); if (cdo) prep_matrix(A.in[26] + (size_t)D * FF, FF, D, WDN1, 0, 0, cscr, cgw, cngw, lane); } }
    SEAM(12);
    PH(13) { pg8::Gemm g{ACT, WDN1, MP, D, FF};
#if SPLITK
        SplitOrder S; S.init(D, FF, SPLITK, G, bid); EpiRes<1, true, false> E{XRES, nullptr, nullptr, nullptr, nullptr}; EpiMux<EpiRes<1, true, false>> EM{E, PART, D}; pg8::gemm_phase<EpiMux<EpiRes<1, true, false>>, SplitOrder, true, true>(lds, g, S, EM);
        grid.sync(); reduce_partials<SPLITK>(PART, D, G, bid); grid.sync(); finalize_sample(E, PART, D, 1, G, bid);
#else
        pg8::StaticOrder S; S.init(MP, D, G, bid, FF); EpiRes<1, false, false> E{XRES, nullptr, nullptr, nullptr, nullptr}; pg8::gemm_phase<EpiRes<1, false, false>, pg8::StaticOrder, true, true>(lds, g, S, E);
#endif
        }
    SEAM(13);
    PH(14) rms_rows<true>(XRES, nullptr, A.in[27], A.out + O_Y, gw, NGW, lane);
#undef IN
#undef SEAM
}

extern "C" void kernel_launch(void* const* d_in, const int* in_sizes, int n_in, void* d_out, int out_size, void* d_ws, size_t ws_size, hipStream_t stream) {
    static int grid = 0;
    if (grid == 0) {
        if (n_in != 28 || (size_t)out_size != O_END || ws_size < WS_END) { fprintf(stderr, "kernel_launch: unexpected shapes n_in %d out %d ws %zu\n", n_in, out_size, ws_size); grid = -1; return; }
        int dev = 0, cus = 0, per_cu = 0;
        (void)hipGetDevice(&dev); (void)hipDeviceGetAttribute(&cus, hipDeviceAttributeMultiprocessorCount, dev);
        if (hipFuncSetAttribute((const void*)fwd_kernel, hipFuncAttributeMaxDynamicSharedMemorySize, LDS_BYTES) != hipSuccess) { fprintf(stderr, "kernel_launch: hipFuncSetAttribute failed\n"); grid = -1; return; }
        if (hipOccupancyMaxActiveBlocksPerMultiprocessor(&per_cu, (const void*)fwd_kernel, 512, LDS_BYTES) != hipSuccess || per_cu < 1) { fprintf(stderr, "kernel_launch: occupancy query says %d\n", per_cu); per_cu = 1; }
        (void)hipGetLastError();
        grid = cus;
        fprintf(stderr, "kernel_launch: grid %d (cus %d, per_cu %d)\n", grid, cus, per_cu);
    }
    if (grid < 0) return;
    Args a{};
    for (int i = 0; i < 28; ++i) a.in[i] = (const float*)d_in[i];
    a.out = (float*)d_out; a.ws = (unsigned char*)d_ws;
#if ONE_LAUNCH
    a.ph_lo = 0; a.ph_hi = NPH;
    void* args[] = {&a};
    hipError_t e = hipLaunchCooperativeKernel((const void*)fwd_kernel, dim3(grid), dim3(512), args, LDS_BYTES, stream);
    if (e != hipSuccess) fprintf(stderr, "kernel_launch: cooperative launch failed: %s\n", hipGetErrorString(e));
#else
    for (int ph = 0; ph < NPH; ++ph) { a.ph_lo = ph; a.ph_hi = ph + 1; hipLaunchKernelGGL(fwd_kernel, dim3(grid), dim3(512), LDS_BYTES, stream, a); }
#endif
}
```

```cpp
#include <hip/hip_runtime.h>
#include <hip/hip_cooperative_groups.h>
#include <cstdio>
#include <cstdint>
namespace cg = cooperative_groups;
namespace pg8 {
#define PG8_LAS __attribute__((address_space(3)))
typedef unsigned short bf16_t;
typedef short bf16x8 __attribute__((ext_vector_type(8)));
typedef float f32x4 __attribute__((ext_vector_type(4)));
typedef unsigned u32x4 __attribute__((ext_vector_type(4)));
constexpr int BM = 256, BK = 64, HALF = 128, HTB = HALF * BK * 2  , STAGE_BYTES = 8 * HTB, NXCD = 8, WGM = 8;

__host__ __device__ __forceinline__ int lds_byte(int r, int c) { const int st = (r >> 4) * 2 + (c >> 5), rr = r & 15, cc = c & 31, ob = rr * 64 + cc * 2; return st * 1024 + (ob ^ (((ob >> 9) & 1) << 5)); }
__host__ __device__ __forceinline__ void stage_rc(int b, int& R, int& C) { const int st = b / 1024, sb = b % 1024, swz = sb ^ (((sb >> 9) & 1) << 5); R = (st >> 1) * 16 + swz / 64; C = (st & 1) * 32 + (swz % 64) / 2; }
__host__ __device__ __forceinline__ int perm32(int rho) { const int n = rho >> 4, i = rho & 15; return 8 * (i >> 2) + 4 * n + (i & 3); }

struct Unit { int pm, pn, kt0, nkt; };
struct Gemm { const bf16_t* A; const bf16_t* Bt; int M, N, K; };

struct StaticOrder {
    int nM, nN, nwg, G, c, nkt;
    __host__ __device__ __forceinline__ void init(int M, int N, int G_, int c_, int K) { nM = M / BM; nN = N / BM; nwg = nM * nN; G = G_; c = c_; nkt = K / BK; }
    __host__ __device__ __forceinline__ bool next(int i, Unit& u) const {
        const long L = (long)i * G + c; if (L >= nwg) return false;
        int wgid = (int)L; { const int q = nwg / NXCD, r = nwg % NXCD, xcd = wgid % NXCD, off = wgid / NXCD; wgid = (xcd < r ? xcd * (q + 1) : r * (q + 1) + (xcd - r) * q) + off; }
        const int nig = WGM * nN, gid = wgid / nig, fm = gid * WGM, gsz = (nM - fm) < WGM ? (nM - fm) : WGM;
        u.pm = fm + ((wgid % nig) % gsz); u.pn = (wgid % nig) / gsz; u.kt0 = 0; u.nkt = nkt; return true;
    }
    __device__ __forceinline__ void a_ready(const Unit&) const {}
    __device__ __forceinline__ void done(const Unit&) const {}
};
__device__ __forceinline__ unsigned cvt_pk_bf16(float lo, float hi) { unsigned r; asm volatile("v_cvt_pk_bf16_f32 %0, %1, %2" : "=v"(r) : "v"(lo), "v"(hi)); return r; }
typedef float f32x2 __attribute__((ext_vector_type(2)));
template <class Epi, class Sched, bool ALIGN_EPI = false, bool SP2 = false>
__device__ __forceinline__ void gemm_phase(PG8_LAS unsigned char* lds, const Gemm g, const Sched& S, const Epi& E) {
    const int tid = threadIdx.x, wid = __builtin_amdgcn_readfirstlane(tid >> 6), lane = tid & 63, wr = wid >> 2, wc = wid & 3, fr = lane & 15, fq = lane >> 4;
    const int K = g.K;
    unsigned voffA[2], voffB[2];
#pragma unroll
    for (int i = 0; i < 2; ++i) { int R, C; stage_rc(tid * 16 + i * 8192, R, C); const int Rb = Epi::PERM ? ((R & ~31) + perm32(R & 31)) : R;
        voffA[i] = (unsigned)(R * K + C) * 2u; voffB[i] = (unsigned)(Rb * K + C) * 2u; }
    const size_t kstep = (size_t)(BK * 2);
    const size_t hstep = (size_t)HALF * K * 2;
    const size_t tstep = 2 * hstep;
    const unsigned ldsw = (unsigned)wid * 1024u;
    const int aoff = lds_byte(wr * 64 + fr, fq * 8), boff = lds_byte(wc * 32 + fr, fq * 8);
#define PG8_SA(b, h) (((b) * 2 + (h)) * HTB)
#define PG8_SB(b, h) ((4 + (b) * 2 + (h)) * HTB)
#define PG8_STAGE(bufoff, gbase, voff) do { _Pragma("unroll") for (int _i = 0; _i < 2; ++_i) \
        __builtin_amdgcn_global_load_lds((const unsigned*)((const char*)(gbase) + (voff)[_i]), (PG8_LAS unsigned*)(lds + (bufoff) + ldsw + _i * 8192), 16, 0, 0); } while (0)
#define PG8_LDA(dst, b, h) do { _Pragma("unroll") for (int m = 0; m < 4; ++m) _Pragma("unroll") for (int k = 0; k < 2; ++k) dst[m][k] = *(const PG8_LAS bf16x8*)(lds + PG8_SA(b, h) + aoff + m * 2048 + k * 1024); } while (0)
#define PG8_LDB(dst, b, h) do { _Pragma("unroll") for (int n = 0; n < 2; ++n) _Pragma("unroll") for (int k = 0; k < 2; ++k) dst[n][k] = *(const PG8_LAS bf16x8*)(lds + PG8_SB(b, h) + boff + n * 2048 + k * 1024); } while (0)
#define PG8_MMA(ai, bj, At, Bt) do { __builtin_amdgcn_s_setprio(1); _Pragma("unroll") for (int m = 0; m < 4; ++m) _Pragma("unroll") for (int n = 0; n < 2; ++n) _Pragma("unroll") for (int k = 0; k < 2; ++k) \
        acc[ai][bj][m][n] = __builtin_amdgcn_mfma_f32_16x16x32_bf16(Bt[n][k], At[m][k], acc[ai][bj][m][n], 0, 0, 0); __builtin_amdgcn_s_setprio(0); } while (0)
#define PG8_WAIT_V(n) asm volatile("s_waitcnt vmcnt(" #n ")" ::: "memory")
#define PG8_WAIT_L(n) asm volatile("s_waitcnt lgkmcnt(" #n ")" ::: "memory")
#define PG8_BAR __builtin_amdgcn_s_barrier()
#define PG8_SCHED __builtin_amdgcn_sched_barrier(0)
    Unit cur, nxt; int ui = 0;
    if (!S.next(0, cur)) return;
    f32x4 acc[2][2][4][2];
#pragma unroll
    for (int a = 0; a < 2; ++a)
#pragma unroll
        for (int b = 0; b < 2; ++b)
#pragma unroll
            for (int m = 0; m < 4; ++m)
#pragma unroll
                for (int n = 0; n < 2; ++n) acc[a][b][m][n] = (f32x4){0.f, 0.f, 0.f, 0.f};
    bf16x8 At[4][2], B0[2][2], B1[2][2];
    const char* cA = (const char*)g.A + (size_t)cur.pm * tstep + (size_t)cur.kt0 * kstep; const char* cB = (const char*)g.Bt + (size_t)cur.pn * tstep + (size_t)cur.kt0 * kstep;
    S.a_ready(cur);
    if constexpr (SP2) {
        PG8_STAGE(PG8_SB(0, 0), cB, voffB); PG8_STAGE(PG8_SB(0, 1), cB + hstep, voffB); PG8_STAGE(PG8_SA(0, 0), cA, voffA); PG8_STAGE(PG8_SA(0, 1), cA + hstep, voffA);
        if (wr == 1) PG8_BAR;
        PG8_WAIT_V(2); PG8_BAR;
        PG8_STAGE(PG8_SB(1, 0), cB + kstep, voffB); PG8_STAGE(PG8_SA(1, 0), cA + kstep, voffA); PG8_STAGE(PG8_SB(1, 1), cB + hstep + kstep, voffB);
        PG8_WAIT_V(6); PG8_BAR;
    } else {
        PG8_STAGE(PG8_SB(0, 0), cB, voffB); PG8_STAGE(PG8_SA(0, 0), cA, voffA); PG8_STAGE(PG8_SB(0, 1), cB + hstep, voffB); PG8_STAGE(PG8_SA(0, 1), cA + hstep, voffA);
        if (wr == 1) PG8_BAR;
        PG8_WAIT_V(4); PG8_BAR;
        PG8_STAGE(PG8_SB(1, 0), cB + kstep, voffB); PG8_STAGE(PG8_SA(1, 0), cA + kstep, voffA); PG8_STAGE(PG8_SB(1, 1), cB + hstep + kstep, voffB);
        PG8_WAIT_V(6); PG8_BAR;
    }
    for (;;) {
        const bool has_next = S.next(ui + 1, nxt);
        const char* nA = has_next ? (const char*)g.A + (size_t)nxt.pm * tstep + (size_t)nxt.kt0 * kstep : cA; const char* nB = has_next ? (const char*)g.Bt + (size_t)nxt.pn * tstep + (size_t)nxt.kt0 * kstep : cB;
        const int nt = cur.nkt;
        for (int t = 0; t < nt; t += 2) {
            const bool last = (t == nt - 2);
            const char* a1 = cA + (size_t)(t + 1) * kstep;
            const char* a2 = last ? nA : cA + (size_t)(t + 2) * kstep; const char* b2 = last ? nB : cB + (size_t)(t + 2) * kstep;
            const char* a3 = a2 + kstep; const char* b3 = b2 + kstep;
            if (last && has_next) S.a_ready(nxt);
            if constexpr (SP2) {
            PG8_LDB(B0, 0, 0); PG8_LDB(B1, 0, 1); PG8_SCHED; PG8_LDA(At, 0, 0); PG8_STAGE(PG8_SA(1, 1), a1 + hstep, voffA);
            PG8_WAIT_V(8); PG8_WAIT_L(0); PG8_BAR; PG8_MMA(0, 0, At, B0); PG8_MMA(0, 1, At, B1); PG8_BAR; PG8_SCHED;
            PG8_LDA(At, 0, 1); PG8_STAGE(PG8_SB(0, 0), b2, voffB); PG8_STAGE(PG8_SB(0, 1), b2 + hstep, voffB); PG8_STAGE(PG8_SA(0, 0), a2, voffA);
            PG8_WAIT_V(8); PG8_WAIT_L(0); PG8_BAR; PG8_MMA(1, 0, At, B0); PG8_MMA(1, 1, At, B1); PG8_BAR; PG8_SCHED;
            PG8_LDB(B0, 1, 0); PG8_LDB(B1, 1, 1); PG8_SCHED; PG8_LDA(At, 1, 0); PG8_STAGE(PG8_SA(0, 1), a2 + hstep, voffA);
            PG8_WAIT_V(8); PG8_WAIT_L(0); PG8_BAR; PG8_MMA(0, 0, At, B0); PG8_MMA(0, 1, At, B1); PG8_BAR; PG8_SCHED;
            PG8_LDA(At, 1, 1); PG8_STAGE(PG8_SB(1, 0), b3, voffB); PG8_STAGE(PG8_SB(1, 1), b3 + hstep, voffB); PG8_STAGE(PG8_SA(1, 0), a3, voffA);
            PG8_WAIT_V(8); PG8_WAIT_L(0); PG8_BAR; PG8_MMA(1, 0, At, B0); PG8_MMA(1, 1, At, B1); PG8_BAR; PG8_SCHED;
            } else {
            PG8_LDB(B0, 0, 0); PG8_SCHED; PG8_LDA(At, 0, 0); PG8_STAGE(PG8_SA(1, 1), a1 + hstep, voffA);
            PG8_WAIT_L(8); PG8_BAR; PG8_WAIT_L(0); PG8_MMA(0, 0, At, B0); PG8_BAR; PG8_SCHED;
            PG8_LDB(B1, 0, 1); PG8_STAGE(PG8_SB(0, 0), b2, voffB);
            PG8_BAR; PG8_WAIT_L(0); PG8_MMA(0, 1, At, B1); PG8_BAR;
            PG8_LDA(At, 0, 1); PG8_STAGE(PG8_SA(0, 0), a2, voffA);
            PG8_BAR; PG8_WAIT_L(0); PG8_MMA(1, 0, At, B0); PG8_BAR; PG8_SCHED;
            PG8_STAGE(PG8_SB(0, 1), b2 + hstep, voffB);
            PG8_WAIT_V(6); PG8_BAR; PG8_MMA(1, 1, At, B1); PG8_BAR;
            PG8_LDB(B0, 1, 0); PG8_SCHED; PG8_LDA(At, 1, 0); PG8_STAGE(PG8_SA(0, 1), a2 + hstep, voffA);
            PG8_WAIT_L(8); PG8_BAR; PG8_WAIT_L(0); PG8_MMA(0, 0, At, B0); PG8_BAR; PG8_SCHED;
            PG8_LDB(B1, 1, 1); PG8_STAGE(PG8_SB(1, 0), b3, voffB);
            PG8_BAR; PG8_WAIT_L(0); PG8_MMA(0, 1, At, B1); PG8_BAR;
            PG8_LDA(At, 1, 1); PG8_STAGE(PG8_SA(1, 0), a3, voffA);
            PG8_BAR; PG8_WAIT_L(0); PG8_MMA(1, 0, At, B0); PG8_BAR; PG8_SCHED;
            PG8_STAGE(PG8_SB(1, 1), b3 + hstep, voffB);
            PG8_WAIT_V(6); PG8_BAR; PG8_MMA(1, 1, At, B1); PG8_BAR;
            }
        }
        if constexpr (ALIGN_EPI) { if (wr == 0) PG8_BAR; }
        if constexpr (!Epi::AFTER_DRAIN) { E(acc, cur, wr, wc, fr, fq); S.done(cur); }
        if (!has_next) break;
#pragma unroll
        for (int a = 0; a < 2; ++a)
#pragma unroll
            for (int b = 0; b < 2; ++b)
#pragma unroll
                for (int m = 0; m < 4; ++m)
#pragma unroll
                    for (int n = 0; n < 2; ++n) acc[a][b][m][n] = (f32x4){0.f, 0.f, 0.f, 0.f};
        cur = nxt; cA = nA; cB = nB; ++ui;
        if constexpr (ALIGN_EPI) { if (wr == 1) PG8_BAR; }
    }
    PG8_WAIT_V(0);
    if constexpr (!ALIGN_EPI) { if (wr == 0) PG8_BAR; }
    PG8_BAR;
    if constexpr (Epi::AFTER_DRAIN) { E.fused(acc, cur, wr, wc, fr, fq, lds, wid, lane); S.done(cur); }
#undef PG8_SA
#undef PG8_SB
#undef PG8_STAGE
#undef PG8_LDA
#undef PG8_LDB
#undef PG8_MMA
#undef PG8_WAIT_V
#undef PG8_WAIT_L
#undef PG8_BAR
#undef PG8_SCHED
}
}

#define LAS __attribute__((address_space(3)))
typedef pg8::bf16_t bf16_t;
typedef pg8::bf16x8 bf16x8;
typedef pg8::f32x4 f32x4;
typedef pg8::u32x4 u32x4;
typedef unsigned u32x2 __attribute__((ext_vector_type(2)));
typedef float f32x2 __attribute__((ext_vector_type(2)));

#ifndef SPLITK
#define SPLITK 22
#endif
#ifndef ONE_LAUNCH
#define ONE_LAUNCH 1
#endif

constexpr int D = 2048, TP = 8192, MR = 8320, MP = 8448, FF = 5632, NPH = 15;
constexpr float EPS = 1e-6f;
constexpr size_t MiB = (size_t)1 << 20;
constexpr size_t WS_COS = 0, WS_SIN = 1536 * 1024, WS_WIN = 4 * MiB, WS_WOUT = 36 * MiB, WS_WGLU = 44 * MiB, WS_WGU0 = 60 * MiB, WS_WGU1 = 104 * MiB,
                 WS_WDN0 = 148 * MiB, WS_WDN1 = 170 * MiB, WS_XRES = 192 * MiB, WS_H = 258 * MiB, WS_PROJ = 291 * MiB, PSZ = (size_t)MP * 1024 * 2,
                 WS_SSQ = 3 * MiB, WS_XB = 456 * MiB, WS_STR = 456 * MiB, WS_STH = 488 * MiB, WS_PART = 520 * MiB, WS_END = 552 * MiB;
constexpr size_t O_Y = 0, O_RETP = 17039360, O_RETS = 18087936, O_HGP = 51642368, O_HGS = 52166656, O_S5RP = 68943872, O_S5IP = 68976640, O_S5RS = 69009408,
                 O_S5IS = 70057984, O_END = 71106560;
constexpr int LDS_BYTES = 147456;

struct Args { const float* in[28]; float* out; unsigned char* ws; int ph_lo, ph_hi; };

#define LDS_WAIT() asm volatile("s_waitcnt lgkmcnt(0)" ::: "memory")
#define LDS_BARRIER() do { asm volatile("s_waitcnt lgkmcnt(0)" ::: "memory"); __builtin_amdgcn_s_barrier(); asm volatile("" ::: "memory"); } while (0)
#define MFMA16(a, b, c) __builtin_amdgcn_mfma_f32_16x16x32_bf16((a), (b), (c), 0, 0, 0)

__device__ __forceinline__ unsigned pkbf(float lo, float hi) { return pg8::cvt_pk_bf16(lo, hi); }
__device__ __forceinline__ float bflo(unsigned w) { return __uint_as_float(w << 16); }
__device__ __forceinline__ float bfhi(unsigned w) { return __uint_as_float(w & 0xffff0000u); }
__device__ __forceinline__ float bf2f(bf16_t b) { return __uint_as_float(((unsigned)b) << 16); }
__device__ __forceinline__ void st_bf4(bf16_t* p, f32x4 v) { u32x2 w; w.x = pkbf(v[0], v[1]); w.y = pkbf(v[2], v[3]); *(u32x2*)p = w; }
__device__ __forceinline__ float sigm(float x) { return __builtin_amdgcn_rcpf(1.f + __expf(-x)); }
__device__ __forceinline__ float silu(float x) { return x * sigm(x); }
__device__ __forceinline__ int opaque0() { int z; asm volatile("v_mov_b32 %0, 0" : "=v"(z)); return z; }
__device__ __forceinline__ float wave_sum(float v) {
#pragma unroll
    for (int o = 1; o < 64; o <<= 1) v += __shfl_xor(v, o);
    return v;
}
__device__ __forceinline__ float gelu_tanh(float x) {
    const float u = 0.7978845608028654f * (x + 0.044715f * x * x * x);
    const float e = __expf(2.f * u);
    const float th = 1.f - 2.f * __builtin_amdgcn_rcpf(e + 1.f);
    return 0.5f * x * (1.f + th);
}

struct EpiIn {
    static constexpr bool PERM = true, AFTER_DRAIN = false;
    bf16_t* P; float* PB; const float* rcos; const float* rsin; const float* hg_lb;
    __device__ __forceinline__ void operator()(const f32x4 (&acc)[2][2][4][2], const pg8::Unit& u, int wr, int wc, int fr, int fq) const {
        const int sec = u.pn >> 2, hd = u.pn & 3;
        const int rowb = u.pm * 256 + wr * 64 + fr;
        if (sec < 2) {
            bf16_t* O = P + (size_t)sec * (PSZ / 2); const float sc = sec == 0 ? 1.f : 0.0625f;
#pragma unroll
            for (int ai = 0; ai < 2; ++ai)
#pragma unroll
                for (int m = 0; m < 4; ++m) { const int row = rowb + ai * 128 + m * 16;
                    if (row < MR) { const int pidx = row < TP ? (row & 2047) : 2048;
                        const int i0 = wc * 32 + fq * 8; u32x4 w1, w2;
#pragma unroll
                        for (int n = 0; n < 2; ++n) {
                            const f32x4 c = *(const f32x4*)(rcos + pidx * 128 + i0 + 4 * n), s = *(const f32x4*)(rsin + pidx * 128 + i0 + 4 * n);
                            const f32x4 x1 = acc[ai][0][m][n], x2 = acc[ai][1][m][n];
                            const f32x4 o1 = (x1 * c - x2 * s) * sc, o2 = (x1 * s + x2 * c) * sc;
                            if (n == 0) { w1.x = pkbf(o1[0], o1[1]); w1.y = pkbf(o1[2], o1[3]); w2.x = pkbf(o2[0], o2[1]); w2.y = pkbf(o2[2], o2[3]); }
                            else { w1.z = pkbf(o1[0], o1[1]); w1.w = pkbf(o1[2], o1[3]); w2.z = pkbf(o2[0], o2[1]); w2.w = pkbf(o2[2], o2[3]); } }
                        bf16_t* rp = O + (size_t)row * 1024 + hd * 256 + i0;
                        *(u32x4*)rp = w1; *(u32x4*)(rp + 128) = w2; } }
        } else if (sec == 5) {
            bf16_t* OK_ = P + (size_t)5 * (PSZ / 2);
#pragma unroll
            for (int bj = 0; bj < 2; ++bj)
#pragma unroll
                for (int n = 0; n < 2; ++n) { const int col = hd * 256 + bj * 128 + wc * 32 + fq * 8 + n * 4;
                    const f32x4 a0 = *(const f32x4*)(hg_lb + col), a1 = *(const f32x4*)(hg_lb + 1024 + col), a2 = *(const f32x4*)(hg_lb + 2048 + col);
                    f32x4 lb;
#pragma unroll
                    for (int j = 0; j < 4; ++j) { const float mx = fmaxf(a0[j], fmaxf(a1[j], a2[j])); const float e0 = __expf(a0[j] - mx), e1 = __expf(a1[j] - mx), e2 = __expf(a2[j] - mx); lb[j] = e0 / (e0 + e1 + e2); }
#pragma unroll
                    for (int ai = 0; ai < 2; ++ai) { f32x4 lf[4];
#pragma unroll
                        for (int m = 0; m < 4; ++m) { const int row = rowb + ai * 128 + m * 16; f32x4 hk;
#pragma unroll
                            for (int j = 0; j < 4; ++j) { const float g = acc[ai][bj][m][n][j]; const float e = __expf(-g); const float sg = __builtin_amdgcn_rcpf(1.f + e);
                                const float f = lb[j] + (1.f - lb[j]) * sg; lf[m][j] = __logf(f); hk[j] = (1.f - lb[j]) * (e * sg); }
                            if (row < MR) st_bf4(OK_ + (size_t)row * 1024 + col, hk); }
                        if (u.pm < 32) {
                            f32x4 off = {0.f, 0.f, 0.f, 0.f};
#pragma unroll
                            for (int m = 0; m < 4; ++m) { f32x4 s = lf[m];
#pragma unroll
                                for (int d = 1; d < 16; d <<= 1) {
#pragma unroll
                                    for (int j = 0; j < 4; ++j) { const float t = __shfl_up(s[j], d, 16); if (fr >= d) s[j] += t; } }
                                s = s + off;
#pragma unroll
                                for (int j = 0; j < 4; ++j) off[j] = __shfl(s[j], 15, 16);
                                lf[m] = s; }
                        }
#pragma unroll
                        for (int m = 0; m < 4; ++m) { const int row = rowb + ai * 128 + m * 16; if (row < MR) *(f32x4*)(PB + (size_t)row * 1024 + col) = lf[m]; } } }
        } else {
            bf16_t* O = P + (size_t)sec * (PSZ / 2); const bool act = (sec == 3) | (sec == 4) | (sec == 7);
#pragma unroll
            for (int ai = 0; ai < 2; ++ai)
#pragma unroll
                for (int m = 0; m < 4; ++m) { const int row = rowb + ai * 128 + m * 16;
                    if (row < MR) {
#pragma unroll
                        for (int bj = 0; bj < 2; ++bj) { const int col = hd * 256 + bj * 128 + wc * 32 + fq * 8; f32x4 v0 = acc[ai][bj][m][0], v1 = acc[ai][bj][m][1];
                            if (act) {
#pragma unroll
                                for (int j = 0; j < 4; ++j) { v0[j] = silu(v0[j]); v1[j] = silu(v1[j]); } }
                            u32x4 wv; wv.x = pkbf(v0[0], v0[1]); wv.y = pkbf(v0[2], v0[3]); wv.z = pkbf(v1[0], v1[1]); wv.w = pkbf(v1[2], v1[3]);
                            *(u32x4*)(O + (size_t)row * 1024 + col) = wv; } } }
        }
    }
};
template <int MODE, bool SPLIT, bool FUSE> struct EpiRes {
    static constexpr bool PERM = false, AFTER_DRAIN = false;
    float* X; const float* xp; const float* xs; bf16_t* XB; float* SSQ;
    __device__ __forceinline__ void operator()(const f32x4 (&acc)[2][2][4][2], const pg8::Unit& u, int wr, int wc, int fr, int fq) const {
        const int rowb = u.pm * 256 + wr * 64 + fr;
        const bool at = false;
#pragma unroll
        for (int ai = 0; ai < 2; ++ai)
#pragma unroll
            for (int m = 0; m < 4; ++m) { const int row = rowb + ai * 128 + m * 16; float ss = 0.f;
                if (row < MR) { float* xr = X + (size_t)row * D;
                    if (MODE == 2) {
#pragma unroll
                        for (int n = 0; n < 2; ++n) { const int col = u.pn * 128 + wc * 32 + n * 16 + fq * 4; const f32x4 a = acc[ai][0][m][n], b = acc[ai][1][m][n]; f32x4 r = *(const f32x4*)(xr + col);
#pragma unroll
                            for (int j = 0; j < 4; ++j) r[j] += a[j] * sigm(b[j]);
                            *(f32x4*)(xr + col) = r;
                            if (FUSE) { if (XB) st_bf4(XB + (size_t)row * D + col, r); ss += (r[0] * r[0] + r[1] * r[1]) + (r[2] * r[2] + r[3] * r[3]); } }
                    } else if (at) {
#pragma unroll
                        for (int bj = 0; bj < 2; ++bj)
#pragma unroll
                            for (int n = 0; n < 2; ++n) { const int col = u.pn * 256 + bj * 128 + wc * 32 + n * 16 + fq * 4;
#pragma unroll
                                for (int j = 0; j < 4; ++j) __hip_atomic_fetch_add(xr + col + j, acc[ai][bj][m][n][j], __ATOMIC_RELAXED, __HIP_MEMORY_SCOPE_AGENT); }
                    } else { const float* br = MODE == 0 ? (row < TP ? xp + (size_t)row * D : xs + (size_t)(row - TP) * D) : xr;
#pragma unroll
                        for (int bj = 0; bj < 2; ++bj)
#pragma unroll
                            for (int n = 0; n < 2; ++n) { const int col = u.pn * 256 + bj * 128 + wc * 32 + n * 16 + fq * 4; const f32x4 r = (MODE == 0 ? __builtin_nontemporal_load((const f32x4*)(br + col)) : *(const f32x4*)(br + col)) + acc[ai][bj][m][n]; *(f32x4*)(xr + col) = r;
                                if (FUSE) { if (XB) st_bf4(XB + (size_t)row * D + col, r); ss += (r[0] * r[0] + r[1] * r[1]) + (r[2] * r[2] + r[3] * r[3]); } } } }
                if (FUSE) { ss += __shfl_xor(ss, 16); ss += __shfl_xor(ss, 32); if (fq == 0 && row < MR) __hip_atomic_fetch_add(SSQ + row, ss, __ATOMIC_RELAXED, __HIP_MEMORY_SCOPE_AGENT); } }
    }
};
struct SplitOrder {
    pg8::StaticOrder so; int nN, NS, nkt_all, G, c, nmain;
    __device__ __forceinline__ void init(int N, int K, int NS_, int G_, int c_) { so.init(TP, N, G_, c_, K); nN = N / 256; NS = NS_; nkt_all = K / 64; G = G_; c = c_; nmain = 32 * nN; }
    __device__ __forceinline__ bool next(int i, pg8::Unit& u) const {
        const long L = (long)i * G + c; const bool mn = L < nmain; const long Ls = L - nmain; if (!mn && Ls >= (long)nN * NS) return false;
        int wgid = mn ? (int)L : 0; { const int nwg = nmain, q = nwg / pg8::NXCD, r = nwg % pg8::NXCD, xcd = wgid % pg8::NXCD, off = wgid / pg8::NXCD; wgid = (xcd < r ? xcd * (q + 1) : r * (q + 1) + (xcd - r) * q) + off; }
        const int nig = pg8::WGM * nN, gid = wgid / nig, fm = gid * pg8::WGM, gsz = (32 - fm) < pg8::WGM ? (32 - fm) : pg8::WGM;
        const int pm_m = fm + ((wgid % nig) % gsz), pn_m = (wgid % nig) / gsz; const int ks = mn ? 0 : (int)(Ls / nN), sub = nkt_all / NS;
        u.pm = mn ? pm_m : 32; u.pn = mn ? pn_m : (int)(Ls % nN); u.nkt = mn ? nkt_all : sub; u.kt0 = ks * sub; return true; }
    __device__ __forceinline__ void a_ready(const pg8::Unit&) const {}
    __device__ __forceinline__ void done(const pg8::Unit&) const {}
};
template <class E> struct EpiMux {
    static constexpr bool PERM = false, AFTER_DRAIN = false;
    E e; float* PART; int N;
    __device__ __forceinline__ void operator()(const f32x4 (&acc)[2][2][4][2], const pg8::Unit& u, int wr, int wc, int fr, int fq) const {
        if (u.pm == 32) { const int ks = u.kt0 / u.nkt; float* pb = PART + ((size_t)ks * 128 + wr * 64 + fr) * N + u.pn * 256 + wc * 32 + fq * 4;
#pragma unroll
            for (int m = 0; m < 4; ++m)
#pragma unroll
                for (int bj = 0; bj < 2; ++bj)
#pragma unroll
                    for (int n = 0; n < 2; ++n) *(f32x4*)(pb + (size_t)(m * 16) * N + bj * 128 + n * 16) = acc[0][bj][m][n];
        } else e(acc, u, wr, wc, fr, fq);
    }
};
template <int NS> __device__ __forceinline__ void reduce_partials(float* PART, int N, int G, int bid) {
    const size_t slab = (size_t)128 * N; const int nv = (int)(slab / 4);
    for (int idx = bid * 512 + (int)threadIdx.x; idx < nv; idx += G * 512) { f32x4 v[NS];
#pragma unroll
        for (int ks = 0; ks < NS; ++ks) v[ks] = *(const f32x4*)(PART + (size_t)ks * slab + (size_t)idx * 4);
        f32x4 t = v[0];
#pragma unroll
        for (int ks = 1; ks < NS; ++ks) t = t + v[ks];
        *(f32x4*)(PART + (size_t)idx * 4) = t; }
}
template <class E> __device__ __forceinline__ void finalize_sample(const E& e, const float* PART, int N, int NS, int G, int bid) {
    const int tid = threadIdx.x + opaque0(), lane = tid & 63, wid = __builtin_amdgcn_readfirstlane(tid >> 6), wr = wid >> 2, wc = wid & 3, fr = lane & 15, fq = lane >> 4;
    for (int pn = bid; pn < N / 256; pn += G) {
        f32x4 acc[2][2][4][2];
#pragma unroll
        for (int a = 0; a < 2; ++a)
#pragma unroll
            for (int b = 0; b < 2; ++b)
#pragma unroll
                for (int m = 0; m < 4; ++m)
#pragma unroll
                    for (int n = 0; n < 2; ++n) acc[a][b][m][n] = (f32x4){0.f, 0.f, 0.f, 0.f};
        const float* pb = PART + ((size_t)wr * 64 + fr) * N + pn * 256 + wc * 32 + fq * 4;
#pragma unroll 1
        for (int ks = 0; ks < NS; ++ks) {
#pragma unroll
            for (int m = 0; m < 4; ++m)
#pragma unroll
                for (int bj = 0; bj < 2; ++bj)
#pragma unroll
                    for (int n = 0; n < 2; ++n) acc[0][bj][m][n] = acc[0][bj][m][n] + *(const f32x4*)(pb + ((size_t)ks * 128 + m * 16) * N + bj * 128 + n * 16); }
        pg8::Unit u; u.pm = 32; u.pn = pn; u.kt0 = 0; u.nkt = 1;
        e(acc, u, wr, wc, fr, fq);
    }
}
struct EpiGU {
    static constexpr bool PERM = true, AFTER_DRAIN = false;
    bf16_t* A; const float* SSQ;
    __device__ __forceinline__ void operator()(const f32x4 (&acc)[2][2][4][2], const pg8::Unit& u, int wr, int wc, int fr, int fq) const {
        const int rowb = u.pm * 256 + wr * 64 + fr;
        const int col = u.pn * 128 + wc * 32 + fq * 8;
#pragma unroll
        for (int ai = 0; ai < 2; ++ai)
#pragma unroll
            for (int m = 0; m < 4; ++m) { const int row = rowb + ai * 128 + m * 16;
                if (row < MR) { const float rstd = rsqrtf(SSQ[row] * (1.f / D) + EPS);
                    const f32x4 g0 = acc[ai][0][m][0] * rstd, g1 = acc[ai][0][m][1] * rstd, u0 = acc[ai][1][m][0] * rstd, u1 = acc[ai][1][m][1] * rstd; f32x4 v0, v1;
#pragma unroll
                    for (int j = 0; j < 4; ++j) { v0[j] = silu(g0[j]) * u0[j]; v1[j] = silu(g1[j]) * u1[j]; }
                    u32x4 wv; wv.x = pkbf(v0[0], v0[1]); wv.y = pkbf(v0[2], v0[3]); wv.z = pkbf(v1[0], v1[1]); wv.w = pkbf(v1[2], v1[3]);
                    __builtin_nontemporal_store(wv, (u32x4*)(A + (size_t)row * FF + col)); } }
    }
};

__device__ __forceinline__ void transpose_item(const float* W, int K, int N, bf16_t* WT, int dst_row, LAS float* scr, int k0, int n0, int lane, const float* gain) {
#pragma unroll
    for (int i = 0; i < 32; ++i) { const int kk = 2 * i + (lane >> 5); scr[kk * 33 + (lane & 31)] = __builtin_nontemporal_load(W + (size_t)(k0 + kk) * N + n0 + (lane & 31)); }
    LDS_WAIT();
    const int c = lane & 7;
    f32x4 g0 = {1.f, 1.f, 1.f, 1.f}, g1 = g0;
    if (gain) { g0 = *(const f32x4*)(gain + k0 + 8 * c); g1 = *(const f32x4*)(gain + k0 + 8 * c + 4); }
#pragma unroll
    for (int j = 0; j < 4; ++j) { const int n = (lane >> 3) + 8 * j; const LAS float* s = scr + (8 * c) * 33 + n;
        u32x4 o; o.x = pkbf(s[0 * 33] * g0[0], s[1 * 33] * g0[1]); o.y = pkbf(s[2 * 33] * g0[2], s[3 * 33] * g0[3]); o.z = pkbf(s[4 * 33] * g1[0], s[5 * 33] * g1[1]); o.w = pkbf(s[6 * 33] * g1[2], s[7 * 33] * g1[3]);
        *(u32x4*)(WT + (size_t)(dst_row + n) * K + k0 + 8 * c) = o; }
    LDS_WAIT();
}
__device__ __forceinline__ void prep_matrix(const float* W, int K, int N, bf16_t* WT, int mode, int sel, LAS float* scr, int gw, int NGW, int lane_, const float* gain = nullptr) {
    const int lane = lane_ + opaque0();
    const int nblk = N / 32, items = (K / 64) * nblk;
    for (int it = gw; it < items; it += NGW) { const int kb = it / nblk, nb = it - kb * nblk, n0 = nb * 32;
        const int dst = mode ? ((n0 >> 7) * 256 + sel * 128 + (n0 & 127)) : n0;
        transpose_item(W, K, N, WT, dst, scr, kb * 64, n0, lane, gain); }
}
template <bool OUTF> __device__ __forceinline__ void rms_rows(const float* xa, const float* xb, const float* g, void* out, int gw, int NGW, int lane) {
    for (int row = gw; row < MR; row += NGW) {
        const float* xr = (xb != nullptr && row >= TP) ? xb + (size_t)(row - TP) * D : xa + (size_t)row * D;
        f32x4 v[8]; float s = 0.f;
#pragma unroll
        for (int j = 0; j < 8; ++j) { v[j] = __builtin_nontemporal_load((const f32x4*)(xr + 4 * lane + 256 * j)); s += (v[j][0] * v[j][0] + v[j][1] * v[j][1]) + (v[j][2] * v[j][2] + v[j][3] * v[j][3]); }
        const float rstd = rsqrtf(wave_sum(s) * (1.f / D) + EPS);
#pragma unroll
        for (int j = 0; j < 8; ++j) { const f32x4 gg = *(const f32x4*)(g + 4 * lane + 256 * j); const f32x4 o = v[j] * rstd * gg;
            if (OUTF) __builtin_nontemporal_store(o, (f32x4*)((float*)out + (size_t)row * D + 4 * lane + 256 * j)); else st_bf4((bf16_t*)out + (size_t)row * D + 4 * lane + 256 * j, o); }
    }
}


struct MixPtrs { const bf16_t *PQ, *PK, *PV, *PRG, *PHQ, *PHK, *PHV, *PGG; const float* PB; bf16_t *STR, *STH, *MIX; };

__device__ __forceinline__ void ret_scan_unit(const MixPtrs& p, float* out_state, LAS unsigned char* lds, int unit) {
    const int tid = threadIdx.x + opaque0(), lane = tid & 63, w = __builtin_amdgcn_readfirstlane(tid >> 6), fr = lane & 15, fq = lane >> 4;
    const int dvs = unit & 3, h = (unit >> 2) & 3, b = unit >> 4;
    LAS bf16_t* VT = (LAS bf16_t*)lds;
    LAS bf16_t* KT = (LAS bf16_t*)(lds + 64 * 136 * 2);
    const float gamma = 1.f - exp2f(-5.f - (float)h), lg2 = log2f(gamma), cdec = exp2f(128.f * lg2);
    f32x4 acc[4][2];
#pragma unroll
    for (int a = 0; a < 4; ++a)
#pragma unroll
        for (int c = 0; c < 2; ++c) acc[a][c] = (f32x4){0.f, 0.f, 0.f, 0.f};
    u32x4 rk[8], rv[2];
#define RT_LOAD(n_) do { const int r0_ = b * 2048 + (n_) * 128; \
        _Pragma("unroll") for (int it = 0; it < 8; ++it) { const int id = tid + it * 512; rk[it] = *(const u32x4*)(p.PK + (size_t)(r0_ + (id & 127)) * 1024 + h * 256 + (id >> 7) * 8); } \
        _Pragma("unroll") for (int it = 0; it < 2; ++it) { const int id = tid + it * 512; rv[it] = *(const u32x4*)(p.PV + (size_t)(r0_ + (id & 127)) * 1024 + h * 256 + dvs * 64 + (id >> 7) * 8); } } while (0)
    RT_LOAD(0);
    const float kd = exp2f((float)(127 - (tid & 127)) * lg2);
    for (int n = 0; n < 16; ++n) {
        if (n > 0) { bf16_t* st = p.STR + ((size_t)((b * 4 + h) * 16 + n)) * 65536;
#pragma unroll
            for (int mt = 0; mt < 4; ++mt)
#pragma unroll
                for (int nt = 0; nt < 2; ++nt) st_bf4(st + (size_t)(dvs * 64 + mt * 16 + fr) * 256 + w * 32 + nt * 16 + fq * 4, acc[mt][nt]); }
        LDS_BARRIER();
#pragma unroll
        for (int it = 0; it < 8; ++it) { const int id = tid + it * 512, t = id & 127, cc = id >> 7; const u32x4 v = rk[it];
            LAS bf16_t* d = KT + (cc * 8) * 136 + t;
            const unsigned w0 = pkbf(bflo(v.x) * kd, bfhi(v.x) * kd), w1 = pkbf(bflo(v.y) * kd, bfhi(v.y) * kd), w2 = pkbf(bflo(v.z) * kd, bfhi(v.z) * kd), w3 = pkbf(bflo(v.w) * kd, bfhi(v.w) * kd);
            d[0 * 136] = (bf16_t)w0; d[1 * 136] = (bf16_t)(w0 >> 16); d[2 * 136] = (bf16_t)w1; d[3 * 136] = (bf16_t)(w1 >> 16);
            d[4 * 136] = (bf16_t)w2; d[5 * 136] = (bf16_t)(w2 >> 16); d[6 * 136] = (bf16_t)w3; d[7 * 136] = (bf16_t)(w3 >> 16); }
#pragma unroll
        for (int it = 0; it < 2; ++it) { const int id = tid + it * 512, t = id & 127, cc = id >> 7; const u32x4 v = rv[it];
            LAS bf16_t* d = VT + (cc * 8) * 136 + t;
            d[0 * 136] = (bf16_t)v.x; d[1 * 136] = (bf16_t)(v.x >> 16); d[2 * 136] = (bf16_t)v.y; d[3 * 136] = (bf16_t)(v.y >> 16);
            d[4 * 136] = (bf16_t)v.z; d[5 * 136] = (bf16_t)(v.z >> 16); d[6 * 136] = (bf16_t)v.w; d[7 * 136] = (bf16_t)(v.w >> 16); }
        if (n + 1 < 16) RT_LOAD(n + 1);
        LDS_BARRIER();
#pragma unroll
        for (int a = 0; a < 4; ++a)
#pragma unroll
            for (int c = 0; c < 2; ++c) acc[a][c] = acc[a][c] * cdec;
#pragma unroll
        for (int ks = 0; ks < 4; ++ks) { bf16x8 af[4], bfr[2];
#pragma unroll
            for (int mt = 0; mt < 4; ++mt) af[mt] = *(const LAS bf16x8*)(VT + (mt * 16 + fr) * 136 + ks * 32 + fq * 8);
#pragma unroll
            for (int nt = 0; nt < 2; ++nt) bfr[nt] = *(const LAS bf16x8*)(KT + (w * 32 + nt * 16 + fr) * 136 + ks * 32 + fq * 8);
#pragma unroll
            for (int mt = 0; mt < 4; ++mt)
#pragma unroll
                for (int nt = 0; nt < 2; ++nt) acc[mt][nt] = MFMA16(bfr[nt], af[mt], acc[mt][nt]); }
    }
#undef RT_LOAD
    float* os = out_state + (size_t)(b * 4 + h) * 65536;
#pragma unroll
    for (int mt = 0; mt < 4; ++mt)
#pragma unroll
        for (int nt = 0; nt < 2; ++nt)
#pragma unroll
            for (int j = 0; j < 4; ++j) os[(size_t)(w * 32 + nt * 16 + fq * 4 + j) * 256 + dvs * 64 + mt * 16 + fr] = acc[mt][nt][j];
    __syncthreads();
}

__device__ __forceinline__ void hg_scan_unit(const MixPtrs& p, float* out_state, LAS unsigned char* lds, int unit) {
    const int tid = threadIdx.x + opaque0(), lane = tid & 63, w = __builtin_amdgcn_readfirstlane(tid >> 6), fr = lane & 15, fq = lane >> 4;
    const int h = unit & 7, b = unit >> 3;
    LAS bf16_t* VT = (LAS bf16_t*)lds;
    LAS bf16_t* KT = (LAS bf16_t*)(lds + 128 * 72 * 2);
    f32x4 acc[8];
#pragma unroll
    for (int a = 0; a < 8; ++a) acc[a] = (f32x4){0.f, 0.f, 0.f, 0.f};
    u32x4 rk[2], rv[2]; f32x4 rb0[2], rb1[2], rl0[2], rl1[2], rbl;
#define HG_LOAD(n_) do { const int r0_ = b * 2048 + (n_) * 64; \
        _Pragma("unroll") for (int it = 0; it < 2; ++it) { const int id = tid + it * 512, t = id & 63, cc = id >> 6; \
            const size_t go = (size_t)(r0_ + t) * 1024 + h * 128 + cc * 8, gl = (size_t)(r0_ + 63) * 1024 + h * 128 + cc * 8; \
            rk[it] = *(const u32x4*)(p.PHK + go); rb0[it] = *(const f32x4*)(p.PB + go); rb1[it] = *(const f32x4*)(p.PB + go + 4); rl0[it] = *(const f32x4*)(p.PB + gl); rl1[it] = *(const f32x4*)(p.PB + gl + 4); } \
        _Pragma("unroll") for (int it = 0; it < 2; ++it) { const int id = tid + it * 512; rv[it] = *(const u32x4*)(p.PHV + (size_t)(r0_ + (id & 63)) * 1024 + h * 128 + (id >> 6) * 8); } \
        rbl = *(const f32x4*)(p.PB + (size_t)(r0_ + 63) * 1024 + h * 128 + w * 16 + fq * 4); } while (0)
    HG_LOAD(0);
    for (int n = 0; n < 32; ++n) {
        if (n > 0) { bf16_t* st = p.STH + ((size_t)((b * 8 + h) * 32 + n)) * 16384;
#pragma unroll
            for (int mt = 0; mt < 8; ++mt) st_bf4(st + (size_t)(mt * 16 + fr) * 128 + w * 16 + fq * 4, acc[mt]); }
        LDS_BARRIER();
#pragma unroll
        for (int it = 0; it < 2; ++it) { const int id = tid + it * 512, t = id & 63, cc = id >> 6;
            const u32x4 v = rk[it]; const f32x4 b0 = rb0[it], b1 = rb1[it], l0 = rl0[it], l1 = rl1[it];
            LAS bf16_t* d = KT + (cc * 8) * 72 + t;
            const unsigned w0 = pkbf(bflo(v.x) * __expf(l0[0] - b0[0]), bfhi(v.x) * __expf(l0[1] - b0[1])), w1 = pkbf(bflo(v.y) * __expf(l0[2] - b0[2]), bfhi(v.y) * __expf(l0[3] - b0[3]));
            const unsigned w2 = pkbf(bflo(v.z) * __expf(l1[0] - b1[0]), bfhi(v.z) * __expf(l1[1] - b1[1])), w3 = pkbf(bflo(v.w) * __expf(l1[2] - b1[2]), bfhi(v.w) * __expf(l1[3] - b1[3]));
            d[0 * 72] = (bf16_t)w0; d[1 * 72] = (bf16_t)(w0 >> 16); d[2 * 72] = (bf16_t)w1; d[3 * 72] = (bf16_t)(w1 >> 16);
            d[4 * 72] = (bf16_t)w2; d[5 * 72] = (bf16_t)(w2 >> 16); d[6 * 72] = (bf16_t)w3; d[7 * 72] = (bf16_t)(w3 >> 16); }
#pragma unroll
        for (int it = 0; it < 2; ++it) { const int id = tid + it * 512, t = id & 63, cc = id >> 6; const u32x4 v = rv[it];
            LAS bf16_t* d = VT + (cc * 8) * 72 + t;
            d[0 * 72] = (bf16_t)v.x; d[1 * 72] = (bf16_t)(v.x >> 16); d[2 * 72] = (bf16_t)v.y; d[3 * 72] = (bf16_t)(v.y >> 16);
            d[4 * 72] = (bf16_t)v.z; d[5 * 72] = (bf16_t)(v.z >> 16); d[6 * 72] = (bf16_t)v.w; d[7 * 72] = (bf16_t)(v.w >> 16); }
        f32x4 e4;
#pragma unroll
        for (int j = 0; j < 4; ++j) e4[j] = __expf(rbl[j]);
        if (n + 1 < 32) HG_LOAD(n + 1);
        LDS_BARRIER();
#pragma unroll
        for (int a = 0; a < 8; ++a) acc[a] = acc[a] * e4;
#pragma unroll
        for (int ks = 0; ks < 2; ++ks) { const bf16x8 bfr = *(const LAS bf16x8*)(KT + (w * 16 + fr) * 72 + ks * 32 + fq * 8);
#pragma unroll
            for (int mt = 0; mt < 8; ++mt) { const bf16x8 af = *(const LAS bf16x8*)(VT + (mt * 16 + fr) * 72 + ks * 32 + fq * 8); acc[mt] = MFMA16(bfr, af, acc[mt]); } }
    }
#undef HG_LOAD
    float* os = out_state + (size_t)(b * 8 + h) * 16384;
#pragma unroll
    for (int mt = 0; mt < 8; ++mt)
#pragma unroll
        for (int j = 0; j < 4; ++j) os[(size_t)(w * 16 + fq * 4 + j) * 128 + mt * 16 + fr] = acc[mt][j];
    __syncthreads();
}

template <bool RET> __device__ __forceinline__ void sample_unit(const MixPtrs& p, const float* s_in, float* s_out, const float* gn_g, LAS unsigned char* lds, int unit) {
    constexpr int DK = RET ? 256 : 128, NH = RET ? 4 : 8, TX = DK / 4, NTY = 512 / TX, NIT = DK / NTY;
    const int tid = threadIdx.x, tx = tid % TX, ty = tid / TX;
    const int h = unit % NH, bs = unit / NH, row = TP + bs;
    const bf16_t* q = (RET ? p.PQ : p.PHQ) + (size_t)row * 1024 + h * DK;
    const bf16_t* k = (RET ? p.PK : p.PHK) + (size_t)row * 1024 + h * DK;
    const bf16_t* v = (RET ? p.PV : p.PHV) + (size_t)row * 1024 + h * DK;
    const float* fb = p.PB + (size_t)row * 1024 + h * DK;
    const u32x2 vv = *(const u32x2*)(v + 4 * tx);
    const f32x4 v4 = {bflo(vv.x), bfhi(vv.x), bflo(vv.y), bfhi(vv.y)};
    const float gamma = 1.f - exp2f(-5.f - (float)h);
    const size_t sb = (size_t)unit * DK * DK;
    LAS f32x4* cf = (LAS f32x4*)(lds + 8192);
    if (tid < DK) { f32x4 c; c[0] = RET ? gamma : __expf(fb[tid]); c[1] = bf2f(k[tid]); c[2] = bf2f(q[tid]); c[3] = 0.f; cf[tid] = c; }
    __syncthreads();
    f32x4 o = {0.f, 0.f, 0.f, 0.f};
#pragma unroll 8
    for (int i = 0; i < NIT; ++i) { const int dk = ty + NTY * i;
        const f32x4 c = cf[dk]; const float dec = c[0], kk = c[1], qq = c[2];
        const f32x4 s = __builtin_nontemporal_load((const f32x4*)(s_in + sb + (size_t)dk * DK + 4 * tx));
        const f32x4 sn = s * dec + v4 * kk;
        __builtin_nontemporal_store(sn, (f32x4*)(s_out + sb + (size_t)dk * DK + 4 * tx));
        o = o + sn * qq; }
    LAS f32x4* red = (LAS f32x4*)lds;
    red[ty * TX + tx] = o;
    __syncthreads();
    if (tid < 64) {
        f32x4 t = {0.f, 0.f, 0.f, 0.f};
        if (tid < TX) {
#pragma unroll 4
            for (int y = 0; y < NTY; ++y) t = t + red[y * TX + tid]; }
        const int col = h * DK + 4 * tid;
        if (RET) { const float mu = wave_sum((t[0] + t[1]) + (t[2] + t[3])) * (1.f / DK); const f32x4 dlt = t - mu;
            const float var = wave_sum((dlt[0] * dlt[0] + dlt[1] * dlt[1]) + (dlt[2] * dlt[2] + dlt[3] * dlt[3])) * (1.f / DK); const float rs = rsqrtf(var + EPS);
            const f32x4 g = *(const f32x4*)(gn_g + col); const u32x2 gw = *(const u32x2*)(p.PRG + (size_t)row * 1024 + col);
            const f32x4 gate = {bflo(gw.x), bfhi(gw.x), bflo(gw.y), bfhi(gw.y)};
            st_bf4(p.MIX + (size_t)row * D + col, dlt * rs * g * gate);
        } else { const float ss = wave_sum((t[0] * t[0] + t[1] * t[1]) + (t[2] * t[2] + t[3] * t[3])) * (1.f / DK); const float rs = rsqrtf(ss + EPS);
            if (tid < TX) { const f32x4 g = *(const f32x4*)(gn_g + col); const u32x2 gw = *(const u32x2*)(p.PGG + (size_t)row * 1024 + col);
                const f32x4 gate = {bflo(gw.x), bfhi(gw.x), bflo(gw.y), bfhi(gw.y)};
                st_bf4(p.MIX + (size_t)row * D + 1024 + col, t * rs * g * gate); } }
    }
    __syncthreads();
}


template <int HALF> __device__ __forceinline__ void ret_qs_half(f32x4 (&o)[16], const bf16x8 (&qf)[8], LAS bf16_t* R0, const bf16_t* st, int tid, int fr, int fq) {
    __syncthreads();
    for (int id = tid; id < 128 * 32; id += 512) { const int rr = id >> 5, cc = id & 31; *(LAS u32x4*)(R0 + rr * 264 + cc * 8) = *(const u32x4*)(st + (size_t)(HALF * 128 + rr) * 256 + cc * 8); }
    __syncthreads();
#pragma unroll
    for (int ks = 0; ks < 8; ++ks) {
#pragma unroll
        for (int nt = 0; nt < 8; ++nt) { const bf16x8 bfr = *(const LAS bf16x8*)(R0 + (nt * 16 + fr) * 264 + ks * 32 + fq * 8); o[HALF * 8 + nt] = MFMA16(bfr, qf[ks], o[HALF * 8 + nt]); }
        __builtin_amdgcn_sched_barrier(0); }
}
__device__ __forceinline__ void ret_out_unit(const MixPtrs& p, const float* gn_g, LAS unsigned char* lds, int unit) {
    const int tid = threadIdx.x + opaque0(), lane = tid & 63, w = __builtin_amdgcn_readfirstlane(tid >> 6), fr = lane & 15, fq = lane >> 4;
    const int n = unit & 15, h = (unit >> 4) & 3, b = unit >> 6;
    const int r0 = b * 2048 + n * 128, i = 16 * w + fr, row = r0 + i;
    LAS bf16_t* R0 = (LAS bf16_t*)lds;
    LAS bf16_t* R1 = (LAS bf16_t*)(lds + 69632);
    const float gamma = 1.f - exp2f(-5.f - (float)h), lg2 = log2f(gamma);
    bf16x8 qf[8];
#pragma unroll
    for (int ks = 0; ks < 8; ++ks) qf[ks] = *(const bf16x8*)(p.PQ + (size_t)row * 1024 + h * 256 + ks * 32 + fq * 8);
    for (int id = tid; id < 128 * 32; id += 512) { const int rr = id >> 5, cc = id & 31; *(LAS u32x4*)(R0 + rr * 264 + cc * 8) = *(const u32x4*)(p.PK + (size_t)(r0 + rr) * 1024 + h * 256 + cc * 8); }
    __syncthreads();
    {   f32x4 att[8];
#pragma unroll
        for (int nt = 0; nt < 8; ++nt) att[nt] = (f32x4){0.f, 0.f, 0.f, 0.f};
#pragma unroll
        for (int ks = 0; ks < 8; ++ks) {
#pragma unroll
            for (int nt = 0; nt < 8; ++nt) { const bf16x8 bfr = *(const LAS bf16x8*)(R0 + (nt * 16 + fr) * 264 + ks * 32 + fq * 8); att[nt] = MFMA16(bfr, qf[ks], att[nt]); }
            __builtin_amdgcn_sched_barrier(0); }
#pragma unroll
        for (int nt = 0; nt < 8; ++nt) { f32x4 a;
#pragma unroll
            for (int jj = 0; jj < 4; ++jj) { const int j = nt * 16 + fq * 4 + jj; a[jj] = (j <= i) ? att[nt][jj] * exp2f(-(float)(j + 1) * lg2) : 0.f; }
            u32x2 wv; wv.x = pkbf(a[0], a[1]); wv.y = pkbf(a[2], a[3]); *(LAS u32x2*)(R1 + i * 136 + nt * 16 + fq * 4) = wv; } }
    __syncthreads();
    for (int id = tid; id < 128 * 32; id += 512) { const int t = id & 127, cc = id >> 7;
        const u32x4 v = *(const u32x4*)(p.PV + (size_t)(r0 + t) * 1024 + h * 256 + cc * 8);
        LAS bf16_t* d = R0 + (cc * 8) * 136 + t;
        d[0 * 136] = (bf16_t)v.x; d[1 * 136] = (bf16_t)(v.x >> 16); d[2 * 136] = (bf16_t)v.y; d[3 * 136] = (bf16_t)(v.y >> 16);
        d[4 * 136] = (bf16_t)v.z; d[5 * 136] = (bf16_t)(v.z >> 16); d[6 * 136] = (bf16_t)v.w; d[7 * 136] = (bf16_t)(v.w >> 16); }
    __syncthreads();
    f32x4 o[16];
#pragma unroll
    for (int nt = 0; nt < 16; ++nt) o[nt] = (f32x4){0.f, 0.f, 0.f, 0.f};
#pragma unroll
    for (int ks = 0; ks < 4; ++ks) { const bf16x8 af = *(const LAS bf16x8*)(R1 + i * 136 + ks * 32 + fq * 8);
#pragma unroll
        for (int nt = 0; nt < 16; ++nt) { const bf16x8 bfr = *(const LAS bf16x8*)(R0 + (nt * 16 + fr) * 136 + ks * 32 + fq * 8); o[nt] = MFMA16(bfr, af, o[nt]); if ((nt & 7) == 7) __builtin_amdgcn_sched_barrier(0); } }
    if (n > 0) { const bf16_t* st = p.STR + ((size_t)((b * 4 + h) * 16 + n)) * 65536;
        ret_qs_half<0>(o, qf, R0, st, tid, fr, fq);
        ret_qs_half<1>(o, qf, R0, st, tid, fr, fq); }
    const float rsc = exp2f((float)(i + 1) * lg2);
    float s1 = 0.f;
#pragma unroll
    for (int nt = 0; nt < 16; ++nt) { o[nt] = o[nt] * rsc; s1 += (o[nt][0] + o[nt][1]) + (o[nt][2] + o[nt][3]); }
    s1 += __shfl_xor(s1, 16); s1 += __shfl_xor(s1, 32);
    const float mu = s1 * (1.f / 256.f);
    float s2 = 0.f;
#pragma unroll
    for (int nt = 0; nt < 16; ++nt) { o[nt] = o[nt] - mu; s2 += (o[nt][0] * o[nt][0] + o[nt][1] * o[nt][1]) + (o[nt][2] * o[nt][2] + o[nt][3] * o[nt][3]); }
    s2 += __shfl_xor(s2, 16); s2 += __shfl_xor(s2, 32);
    const float rs = rsqrtf(s2 * (1.f / 256.f) + EPS);
#pragma unroll
    for (int nt = 0; nt < 16; ++nt) { const int col = h * 256 + nt * 16 + fq * 4; const f32x4 g = *(const f32x4*)(gn_g + col); const u32x2 gw = *(const u32x2*)(p.PRG + (size_t)row * 1024 + col);
        const f32x4 gate = {bflo(gw.x), bfhi(gw.x), bflo(gw.y), bfhi(gw.y)};
        st_bf4(p.MIX + (size_t)row * D + col, o[nt] * rs * g * gate); if ((nt & 3) == 3) __builtin_amdgcn_sched_barrier(0); }
    __syncthreads();
}

__device__ __forceinline__ void hg_out_unit(const MixPtrs& p, const float* gn_g, LAS unsigned char* lds, int unit) {
    const int tid = threadIdx.x + opaque0(), lane = tid & 63, w = __builtin_amdgcn_readfirstlane(tid >> 6), fr = lane & 15, fq = lane >> 4;
    const int c = unit & 31, h = (unit >> 5) & 7, b = unit >> 8;
    const int r0 = b * 2048 + c * 64, rt = w & 3, dh = w >> 2, i = 16 * rt + fr, row = r0 + i;
    LAS bf16_t* K2 = (LAS bf16_t*)lds;
    LAS bf16_t* VT = (LAS bf16_t*)(lds + 17408);
    LAS bf16_t* ST = (LAS bf16_t*)(lds + 35840);
    LAS bf16_t* AT = (LAS bf16_t*)(lds + 70656) + dh * 64 * 72;
    LAS float* SSQ = (LAS float*)(lds + 89088);
    bf16x8 q1f[4], q2f[4];
#pragma unroll
    for (int ks = 0; ks < 4; ++ks) { const size_t go = (size_t)row * 1024 + h * 128 + ks * 32 + fq * 8, gm = (size_t)(r0 + 31) * 1024 + h * 128 + ks * 32 + fq * 8;
        const u32x4 v = *(const u32x4*)(p.PHQ + go);
        const f32x4 b0 = *(const f32x4*)(p.PB + go), b1 = *(const f32x4*)(p.PB + go + 4), m0 = *(const f32x4*)(p.PB + gm), m1 = *(const f32x4*)(p.PB + gm + 4);
        const float x[8] = {bflo(v.x), bfhi(v.x), bflo(v.y), bfhi(v.y), bflo(v.z), bfhi(v.z), bflo(v.w), bfhi(v.w)};
        u32x4 a, bq;
        a.x = pkbf(x[0] * __expf(b0[0]), x[1] * __expf(b0[1])); a.y = pkbf(x[2] * __expf(b0[2]), x[3] * __expf(b0[3]));
        a.z = pkbf(x[4] * __expf(b1[0]), x[5] * __expf(b1[1])); a.w = pkbf(x[6] * __expf(b1[2]), x[7] * __expf(b1[3]));
        bq.x = pkbf(x[0] * __expf(b0[0] - m0[0]), x[1] * __expf(b0[1] - m0[1])); bq.y = pkbf(x[2] * __expf(b0[2] - m0[2]), x[3] * __expf(b0[3] - m0[3]));
        bq.z = pkbf(x[4] * __expf(b1[0] - m1[0]), x[5] * __expf(b1[1] - m1[1])); bq.w = pkbf(x[6] * __expf(b1[2] - m1[2]), x[7] * __expf(b1[3] - m1[3]));
        q1f[ks] = __builtin_bit_cast(bf16x8, a); q2f[ks] = __builtin_bit_cast(bf16x8, bq); }
    for (int id = tid; id < 64 * 16; id += 512) { const int j = id >> 4, cc = id & 15;
        const size_t go = (size_t)(r0 + j) * 1024 + h * 128 + cc * 8, gm = (size_t)(r0 + 31) * 1024 + h * 128 + cc * 8;
        const u32x4 v = *(const u32x4*)(p.PHK + go);
        const f32x4 b0 = *(const f32x4*)(p.PB + go), b1 = *(const f32x4*)(p.PB + go + 4), m0 = *(const f32x4*)(p.PB + gm), m1 = *(const f32x4*)(p.PB + gm + 4);
        u32x4 o;
        o.x = pkbf(bflo(v.x) * __expf(m0[0] - b0[0]), bfhi(v.x) * __expf(m0[1] - b0[1])); o.y = pkbf(bflo(v.y) * __expf(m0[2] - b0[2]), bfhi(v.y) * __expf(m0[3] - b0[3]));
        o.z = pkbf(bflo(v.z) * __expf(m1[0] - b1[0]), bfhi(v.z) * __expf(m1[1] - b1[1])); o.w = pkbf(bflo(v.w) * __expf(m1[2] - b1[2]), bfhi(v.w) * __expf(m1[3] - b1[3]));
        *(LAS u32x4*)(K2 + j * 136 + cc * 8) = o; }
    for (int id = tid; id < 64 * 16; id += 512) { const int t = id & 63, cc = id >> 6;
        const u32x4 v = *(const u32x4*)(p.PHV + (size_t)(r0 + t) * 1024 + h * 128 + cc * 8);
        LAS bf16_t* d = VT + (cc * 8) * 72 + t;
        d[0 * 72] = (bf16_t)v.x; d[1 * 72] = (bf16_t)(v.x >> 16); d[2 * 72] = (bf16_t)v.y; d[3 * 72] = (bf16_t)(v.y >> 16);
        d[4 * 72] = (bf16_t)v.z; d[5 * 72] = (bf16_t)(v.z >> 16); d[6 * 72] = (bf16_t)v.w; d[7 * 72] = (bf16_t)(v.w >> 16); }
    if (c > 0) { const bf16_t* st = p.STH + ((size_t)((b * 8 + h) * 32 + c)) * 16384;
        for (int id = tid; id < 128 * 16; id += 512) { const int rr = id >> 4, cc = id & 15; *(LAS u32x4*)(ST + rr * 136 + cc * 8) = *(const u32x4*)(st + (size_t)rr * 128 + cc * 8); } }
    __syncthreads();
    {   f32x4 att[4];
#pragma unroll
        for (int nt = 0; nt < 4; ++nt) att[nt] = (f32x4){0.f, 0.f, 0.f, 0.f};
#pragma unroll
        for (int ks = 0; ks < 4; ++ks)
#pragma unroll
            for (int nt = 0; nt < 4; ++nt) { const bf16x8 bfr = *(const LAS bf16x8*)(K2 + (nt * 16 + fr) * 136 + ks * 32 + fq * 8); att[nt] = MFMA16(bfr, q2f[ks], att[nt]); }
#pragma unroll
        for (int nt = 0; nt < 4; ++nt) { f32x4 a;
#pragma unroll
            for (int jj = 0; jj < 4; ++jj) { const int j = nt * 16 + fq * 4 + jj; a[jj] = (j <= i) ? att[nt][jj] : 0.f; }
            u32x2 wv; wv.x = pkbf(a[0], a[1]); wv.y = pkbf(a[2], a[3]); *(LAS u32x2*)(AT + i * 72 + nt * 16 + fq * 4) = wv; } }
    __syncthreads();
    f32x4 o[4];
#pragma unroll
    for (int nt = 0; nt < 4; ++nt) o[nt] = (f32x4){0.f, 0.f, 0.f, 0.f};
#pragma unroll
    for (int ks = 0; ks < 2; ++ks) { const bf16x8 af = *(const LAS bf16x8*)(AT + i * 72 + ks * 32 + fq * 8);
#pragma unroll
        for (int nt = 0; nt < 4; ++nt) { const bf16x8 bfr = *(const LAS bf16x8*)(VT + (dh * 64 + nt * 16 + fr) * 72 + ks * 32 + fq * 8); o[nt] = MFMA16(bfr, af, o[nt]); } }
    if (c > 0) {
#pragma unroll
        for (int ks = 0; ks < 4; ++ks)
#pragma unroll
            for (int nt = 0; nt < 4; ++nt) { const bf16x8 bfr = *(const LAS bf16x8*)(ST + (dh * 64 + nt * 16 + fr) * 136 + ks * 32 + fq * 8); o[nt] = MFMA16(bfr, q1f[ks], o[nt]); } }
    float s2 = 0.f;
#pragma unroll
    for (int nt = 0; nt < 4; ++nt) s2 += (o[nt][0] * o[nt][0] + o[nt][1] * o[nt][1]) + (o[nt][2] * o[nt][2] + o[nt][3] * o[nt][3]);
    s2 += __shfl_xor(s2, 16); s2 += __shfl_xor(s2, 32);
    if (fq == 0) SSQ[dh * 64 + i] = s2;
    __syncthreads();
    const float rs = rsqrtf((SSQ[i] + SSQ[64 + i]) * (1.f / 128.f) + EPS);
#pragma unroll
    for (int nt = 0; nt < 4; ++nt) { const int col = h * 128 + dh * 64 + nt * 16 + fq * 4; const f32x4 g = *(const f32x4*)(gn_g + col); const u32x2 gw = *(const u32x2*)(p.PGG + (size_t)row * 1024 + col);
        const f32x4 gate = {bflo(gw.x), bfhi(gw.x), bflo(gw.y), bfhi(gw.y)};
        st_bf4(p.MIX + (size_t)row * D + 1024 + col, o[nt] * rs * g * gate); }
    __syncthreads();
}

struct S5Par { float ar, ai; float bbr[16], bbi[16]; };
__device__ __forceinline__ void s5_setup(const Args& A, int g, int pp, S5Par& P) {
    const float dt = expf(A.in[15][g]); const float lr = A.in[13][g * 64 + pp], li = A.in[14][g * 64 + pp];
    const float mag = expf(lr * dt);
    const double th = (double)li * (double)dt; const double kk = rint(th * 0.15915494309189535); const float r = (float)(th - kk * 6.283185307179586);
    const float ar = mag * cosf(r), ai = mag * sinf(r);
    const float den = lr * lr + li * li; const float cr = ((ar - 1.f) * lr + ai * li) / den, ci = (ai * lr - (ar - 1.f) * li) / den;
    P.ar = ar; P.ai = ai;
    const float* br = A.in[16] + (size_t)(g * 64 + pp) * 16; const float* bi = A.in[17] + (size_t)(g * 64 + pp) * 16;
#pragma unroll
    for (int q = 0; q < 4; ++q) { const f32x4 r4 = *(const f32x4*)(br + 4 * q), i4 = *(const f32x4*)(bi + 4 * q);
#pragma unroll
        for (int j = 0; j < 4; ++j) { P.bbr[4 * q + j] = cr * r4[j] - ci * i4[j]; P.bbi[4 * q + j] = cr * i4[j] + ci * r4[j]; } }
}
__device__ __forceinline__ f32x4 ldn(const float* p, float rs, const f32x4& gn) { return *(const f32x4*)p * rs * gn; }
template <bool FULL> __device__ __forceinline__ void s5_tile(const float* HF, const float* SSQ, const f32x4& gA, const f32x4& gB, const f32x4& gC, bf16_t* Z, int g, int t0, int tnext, int lane, int fr, int fq, LAS float* BU, LAS bf16_t* HSb,
                                                            const bf16x8 (&bbf)[8], const bf16x8 (&cf)[4], float ar, float ai, float& hr, float& hi, const f32x4& dsk, f32x4& pu0, f32x4& pu1, f32x4& pu4) {
    const f32x4 u0 = pu0, u1 = pu1, u4 = pu4;
    {   const float* up = HF + (size_t)(tnext + fr) * D + g * 16;
        const float rs = rsqrtf(SSQ[tnext + fr] * (1.f / D) + EPS);
        pu0 = ldn(up + 8 * (fq & 1), rs, gA); pu1 = ldn(up + 8 * (fq & 1) + 4, rs, gB); if (FULL) pu4 = ldn(up + 4 * fq, rs, gC); }
    u32x4 uw; uw.x = pkbf(u0[0], u0[1]); uw.y = pkbf(u0[2], u0[3]); uw.z = pkbf(u1[0], u1[1]); uw.w = pkbf(u1[2], u1[3]);
    const bf16x8 uf = __builtin_bit_cast(bf16x8, uw);
#pragma unroll
    for (int nt = 0; nt < 8; ++nt) { const f32x4 z4 = {0.f, 0.f, 0.f, 0.f}; const f32x4 acc = MFMA16(bbf[nt], uf, z4); *(LAS f32x4*)(BU + fr * 144 + nt * 16 + 4 * fq) = acc; }
    LDS_WAIT();
    f32x2 bu[16];
#pragma unroll
    for (int t = 0; t < 16; ++t) bu[t] = *(const LAS f32x2*)(BU + t * 144 + 2 * lane);
#pragma unroll
    for (int t = 0; t < 16; ++t) { const float nr = ar * hr - ai * hi + bu[t].x, ni = ar * hi + ai * hr + bu[t].y; hr = nr; hi = ni;
        if (FULL) *(LAS unsigned*)(HSb + t * 144 + 2 * lane) = pkbf(hr, hi); }
    LDS_WAIT();
    if (FULL) {
        f32x4 y = {0.f, 0.f, 0.f, 0.f};
#pragma unroll
        for (int ks = 0; ks < 4; ++ks) { const bf16x8 af = *(const LAS bf16x8*)(HSb + fr * 144 + ks * 32 + fq * 8); y = MFMA16(cf[ks], af, y); }
        f32x4 z;
#pragma unroll
        for (int e = 0; e < 4; ++e) z[e] = gelu_tanh(y[e] + dsk[e] * u4[e]);
        st_bf4(Z + (size_t)(t0 + fr) * D + g * 16 + 4 * fq, z);
        LDS_WAIT();
    }
}
__device__ __forceinline__ void s5_prompt_unit(const Args& A, const float* HF, const float* SSQ, bf16_t* Z, LAS unsigned char* lds, int unit) {
    const int tid = threadIdx.x + opaque0(), lane = tid & 63, w = __builtin_amdgcn_readfirstlane(tid >> 6), fr = lane & 15, fq = lane >> 4;
    const int g = unit & 127, b = unit >> 7;
    LAS float* BU = (LAS float*)(lds + w * 13824);
    LAS bf16_t* HSb = (LAS bf16_t*)(lds + w * 13824 + 9216);
    LAS float* BT = (LAS float*)(lds + 110592);
    LAS f32x2* CAR = (LAS f32x2*)(lds + 110592 + 8192);
    float ar, ai;
    {   S5Par P; s5_setup(A, g, lane, P); ar = P.ar; ai = P.ai;
        if (w == 0) {
#pragma unroll
            for (int q = 0; q < 4; ++q) { *(LAS f32x4*)(BT + (2 * lane) * 16 + 4 * q) = (f32x4){P.bbr[4 * q], P.bbr[4 * q + 1], P.bbr[4 * q + 2], P.bbr[4 * q + 3]};
                *(LAS f32x4*)(BT + (2 * lane + 1) * 16 + 4 * q) = (f32x4){P.bbi[4 * q], P.bbi[4 * q + 1], P.bbi[4 * q + 2], P.bbi[4 * q + 3]}; } } }
    __syncthreads();
    bf16x8 bbf[8], cf[4];
#pragma unroll
    for (int nt = 0; nt < 8; ++nt) { const LAS float* src = BT + (nt * 16 + fr) * 16 + 8 * (fq & 1); const f32x4 x0 = *(const LAS f32x4*)src, x1 = *(const LAS f32x4*)(src + 4);
        float v[8] = {x0[0], x0[1], x0[2], x0[3], x1[0], x1[1], x1[2], x1[3]};
        if (fq >= 2) {
#pragma unroll
            for (int e = 0; e < 8; ++e) v[e] = v[e] - __uint_as_float(pkbf(v[e], 0.f) << 16); }
        u32x4 o; o.x = pkbf(v[0], v[1]); o.y = pkbf(v[2], v[3]); o.z = pkbf(v[4], v[5]); o.w = pkbf(v[6], v[7]);
        bbf[nt] = __builtin_bit_cast(bf16x8, o); }
#pragma unroll
    for (int ks = 0; ks < 4; ++ks) { const size_t co = (size_t)(g * 16 + fr) * 64 + ks * 16 + fq * 4; const f32x4 cre = *(const f32x4*)(A.in[18] + co), cim = *(const f32x4*)(A.in[19] + co);
        u32x4 o; o.x = pkbf(cre[0], -cim[0]); o.y = pkbf(cre[1], -cim[1]); o.z = pkbf(cre[2], -cim[2]); o.w = pkbf(cre[3], -cim[3]);
        cf[ks] = __builtin_bit_cast(bf16x8, o); }
    const f32x4 dsk = *(const f32x4*)(A.in[20] + g * 16 + 4 * fq);
    const int rowb = b * 2048 + w * 256;
    float hr = 0.f, hi = 0.f;
    f32x4 pu0, pu1, pu4 = {0.f, 0.f, 0.f, 0.f};
    const float* gnp = A.in[12] + g * 16; const f32x4 gA = *(const f32x4*)(gnp + 8 * (fq & 1)), gB = *(const f32x4*)(gnp + 8 * (fq & 1) + 4), gC = *(const f32x4*)(gnp + 4 * fq);
    const float rs0 = rsqrtf(SSQ[rowb + fr] * (1.f / D) + EPS);
    {   const float* up = HF + (size_t)(rowb + fr) * D + g * 16; pu0 = ldn(up + 8 * (fq & 1), rs0, gA); pu1 = ldn(up + 8 * (fq & 1) + 4, rs0, gB); }
    for (int tile = 0; tile < 16; ++tile) s5_tile<false>(HF, SSQ, gA, gB, gC, Z, g, rowb + tile * 16, rowb + (tile < 15 ? tile + 1 : 0) * 16, lane, fr, fq, BU, HSb, bbf, cf, ar, ai, hr, hi, dsk, pu0, pu1, pu4);
    pu4 = ldn(HF + (size_t)(rowb + fr) * D + g * 16 + 4 * fq, rs0, gC);
    { f32x2 e; e.x = hr; e.y = hi; CAR[w * 64 + lane] = e; }
    __syncthreads();
    float pr = ar, pi = ai;
#pragma unroll
    for (int s = 0; s < 8; ++s) { const float t = pr * pr - pi * pi; pi = 2.f * pr * pi; pr = t; }
    hr = 0.f; hi = 0.f;
    for (int v = 0; v < w; ++v) { const f32x2 e = CAR[v * 64 + lane]; const float nr = pr * hr - pi * hi + e.x, ni = pr * hi + pi * hr + e.y; hr = nr; hi = ni; }
    for (int tile = 0; tile < 16; ++tile) s5_tile<true>(HF, SSQ, gA, gB, gC, Z, g, rowb + tile * 16, rowb + (tile < 15 ? tile + 1 : 15) * 16, lane, fr, fq, BU, HSb, bbf, cf, ar, ai, hr, hi, dsk, pu0, pu1, pu4);
    if (w == 7) { A.out[O_S5RP + (size_t)(b * 128 + g) * 64 + lane] = hr; A.out[O_S5IP + (size_t)(b * 128 + g) * 64 + lane] = hi; }
    __syncthreads();
}
__device__ __forceinline__ void s5_sample_unit(const Args& A, const float* HF, const float* SSQ, bf16_t* Z, LAS unsigned char* lds, int gq) {
    const int g = gq & 127, bs0 = (gq >> 7) * 64;
    const int tid = threadIdx.x, lane = tid & 63, w = __builtin_amdgcn_readfirstlane(tid >> 6);
    LAS f32x2* HS = (LAS f32x2*)lds + w * 64;
    LAS f32x2* CT = (LAS f32x2*)(lds + 4096);
    S5Par P; s5_setup(A, g, lane, P);
    for (int id = tid; id < 1024; id += 512) { const int c = id >> 6, pp = id & 63; f32x2 v; v.x = A.in[18][(size_t)(g * 16 + c) * 64 + pp]; v.y = A.in[19][(size_t)(g * 16 + c) * 64 + pp]; CT[pp * 16 + c] = v; }
    __syncthreads();
    for (int bs = bs0 + w; bs < bs0 + 64; bs += 8) {
        const float* up = HF + (size_t)(TP + bs) * D + g * 16; const float rs = rsqrtf(SSQ[TP + bs] * (1.f / D) + EPS); const float* gnp = A.in[12] + g * 16;
        const size_t so = (size_t)(bs * 128 + g) * 64 + lane;
        const float h0r = A.in[4][so], h0i = A.in[5][so];
        float br = 0.f, bi = 0.f;
#pragma unroll
        for (int q = 0; q < 4; ++q) { const f32x4 u4 = *(const f32x4*)(up + 4 * q) * rs * *(const f32x4*)(gnp + 4 * q);
#pragma unroll
            for (int e = 0; e < 4; ++e) { br += P.bbr[4 * q + e] * u4[e]; bi += P.bbi[4 * q + e] * u4[e]; } }
        const float hr = P.ar * h0r - P.ai * h0i + br, hi = P.ar * h0i + P.ai * h0r + bi;
        A.out[O_S5RS + so] = hr; A.out[O_S5IS + so] = hi;
        f32x2 hv; hv.x = hr; hv.y = hi; HS[lane] = hv;
        LDS_WAIT();
        const int c = lane & 15;
        float y = 0.f;
#pragma unroll 8
        for (int pp = 0; pp < 64; ++pp) { const f32x2 h2 = HS[pp]; const f32x2 cc = CT[pp * 16 + c]; y += cc.x * h2.x - cc.y * h2.y; }
        const float z = gelu_tanh(y + A.in[20][g * 16 + c] * (up[c] * rs * gnp[c]));
        if (lane < 16) Z[(size_t)(TP + bs) * D + g * 16 + c] = (bf16_t)(pkbf(z, 0.f) & 0xffffu);
        LDS_WAIT();
    }
    __syncthreads();
}

__global__ void __launch_bounds__(512) fwd_kernel(Args A) {
    extern __shared__ __attribute__((aligned(16))) unsigned char lds_raw[];
    LAS unsigned char* lds = (LAS unsigned char*)lds_raw;
    cg::grid_group grid = cg::this_grid();
    const int tid = threadIdx.x, lane = tid & 63, wave = __builtin_amdgcn_readfirstlane(tid >> 6);
    const int G = gridDim.x, bid = blockIdx.x, gw = bid * 8 + wave, NGW = G * 8;
    unsigned char* ws = A.ws;
    bf16_t* WIN = (bf16_t*)(ws + WS_WIN); bf16_t* WOUT = (bf16_t*)(ws + WS_WOUT); bf16_t* WGLU = (bf16_t*)(ws + WS_WGLU);
    bf16_t* WGU0 = (bf16_t*)(ws + WS_WGU0); bf16_t* WGU1 = (bf16_t*)(ws + WS_WGU1); bf16_t* WDN0 = (bf16_t*)(ws + WS_WDN0); bf16_t* WDN1 = (bf16_t*)(ws + WS_WDN1);
    float* XRES = (float*)(ws + WS_XRES); bf16_t* H = (bf16_t*)(ws + WS_H); bf16_t* PROJ = (bf16_t*)(ws + WS_PROJ); float* PB = (float*)(ws + WS_PROJ + 8 * PSZ);
    bf16_t* ACT = (bf16_t*)(ws + WS_PROJ); float* HF = (float*)(ws + WS_PROJ);
    float* RCOS = (float*)(ws + WS_COS); float* RSIN = (float*)(ws + WS_SIN); float* SSQ0 = (float*)(ws + WS_SSQ); float* SSQ1 = SSQ0 + MP; float* SSQ2 = SSQ0 + 2 * MP; unsigned* WQ = (unsigned*)(SSQ0 + 3 * MP); bf16_t* XB = (bf16_t*)(ws + WS_XB); float* PART = (float*)(ws + WS_PART);
    MixPtrs mp; mp.PQ = PROJ; mp.PK = PROJ + PSZ / 2; mp.PV = PROJ + 2 * (PSZ / 2); mp.PRG = PROJ + 3 * (PSZ / 2); mp.PHQ = PROJ + 4 * (PSZ / 2); mp.PHK = PROJ + 5 * (PSZ / 2);
    mp.PHV = PROJ + 6 * (PSZ / 2); mp.PGG = PROJ + 7 * (PSZ / 2); mp.PB = PB; mp.STR = (bf16_t*)(ws + WS_STR); mp.STH = (bf16_t*)(ws + WS_STH); mp.MIX = H;
    const int lo = A.ph_lo, hi = A.ph_hi;
    LAS float* cscr = (LAS float*)(lds + wave * 8448);
#define CONV_SETUP(nunits) const int cfirst = (nunits) % G; const bool cdo = bid >= cfirst; const int cgw = (bid - cfirst) * 8 + wave, cngw = (G - cfirst) * 8
#ifndef PHMASK
#define PHMASK 0x7fff
#endif
#define IN(k) (((PHMASK >> (k)) & 1) && lo <= (k) && (k) < hi)
#define SEAM(k) do { if (IN(k) && IN((k) + 1)) grid.sync(); } while (0)
#ifndef REPMASK
#define REPMASK 0
#endif
#define REPN(k) (((REPMASK >> (k)) & 1) ? 2 : 1)
#define PH(k) for (int rep_ = 0; rep_ < REPN(k); ++rep_, (rep_ < REPN(k) ? grid.sync() : (void)0)) if (IN(k))

#ifdef EXTRASYNC
    for (int es = 0; es < EXTRASYNC; ++es) grid.sync();
#endif
    PH(0) {
        LAS float* scr = (LAS float*)(lds + wave * 8448);
        prep_matrix(A.in[7], D, 8192, WIN, 0, 0, scr, gw, NGW, lane);
        for (int idx = bid * 512 + tid; idx < 2049 * 128; idx += G * 512) { const int pidx = idx >> 7, i = idx & 127;
            double inv = 1.0, pw = 0.9305720409296989;
#pragma unroll
            for (int k = 0; k < 7; ++k) { if ((i >> k) & 1) inv *= pw; pw *= pw; }
            const double ang = (pidx < 2048 ? (double)pidx : 16384.0) * inv; const double kk = rint(ang * 0.15915494309189535);
            const float r = (float)((ang - kk * 6.283185307179586) - kk * 2.4492935982947064e-16);
            RCOS[idx] = cosf(r); RSIN[idx] = sinf(r); }
        rms_rows<false>(A.in[0], A.in[1], A.in[6], H, gw, NGW, lane);
        for (int idx = bid * 512 + tid; idx < 3 * MP + 64; idx += G * 512) SSQ0[idx] = 0.f;
    }
    SEAM(0);
    PH(1) {
        pg8::Gemm g{H, WIN, MP, 8192, D}; pg8::StaticOrder S; S.init(MP, 8192, G, bid, D);
        EpiIn E{PROJ, PB, RCOS, RSIN, A.in[9]};
        pg8::gemm_phase<EpiIn, pg8::StaticOrder, true, true>(lds, g, S, E);
        {   CONV_SETUP(33 * 32);
            if (cdo) { prep_matrix(A.in[11], D, D, WOUT, 0, 0, cscr, cgw, cngw, lane);
                prep_matrix(A.in[24], D, FF, WGU0, 1, 0, cscr, cgw, cngw, lane, A.in[23]); } }
    }
    SEAM(1);
    PH(2) {
#ifndef REPSUB
#define REPSUB 0
#endif
        for (int u = bid; u < 96; u += G) { if (u >= 32) ret_scan_unit(mp, A.out + O_RETP, lds, u - 32); else hg_scan_unit(mp, A.out + O_HGP, lds, u); }
        for (;;) {
            LAS int* slot = (LAS int*)(lds + 16384);
            if (tid == 0) *slot = (int)__hip_atomic_fetch_add(WQ, 1u, __ATOMIC_RELAXED, __HIP_MEMORY_SCOPE_AGENT);
            __syncthreads();
            const int u = __builtin_amdgcn_readfirstlane(*slot);
            if (u >= 512 + 1024) break;
            if (u < 512) sample_unit<true>(mp, A.in[2], A.out + O_RETS, A.in[8], lds, u);
            else sample_unit<false>(mp, A.in[3], A.out + O_HGS, A.in[10], lds, u - 512);
        }
    }
    SEAM(2);
    PH(3) {
        for (int u = bid; u < 256 + 1024; u += G) {

#ifndef NO_RET_OUT
            if (u < 256) ret_out_unit(mp, A.in[8], lds, u);
#endif
#ifndef NO_HG_OUT
            if (u >= 256) hg_out_unit(mp, A.in[10], lds, u - 256);
#endif

        }
    }
    SEAM(3);
    PH(4) {
        pg8::Gemm g{H, WOUT, MP, D, D}; pg8::StaticOrder S; S.init(MP, D, G, bid, D);
        EpiRes<0, false, true> E{XRES, A.in[0], A.in[1], XB, SSQ0};
        pg8::gemm_phase<EpiRes<0, false, true>, pg8::StaticOrder, true, true>(lds, g, S, E);
        {   CONV_SETUP(33 * 8);
            if (cdo) { prep_matrix(A.in[25], D, FF, WGU0, 1, 1, cscr, cgw, cngw, lane, A.in[23]);
                prep_matrix(A.in[26], FF, D, WDN0, 0, 0, cscr, cgw, cngw, lane); } }
    }
    SEAM(4);
    PH(6) { pg8::Gemm g{XB, WGU0, MP, 2 * FF, D}; pg8::StaticOrder S; S.init(MP, 2 * FF, G, bid, D); EpiGU E{ACT, SSQ0}; pg8::gemm_phase<EpiGU, pg8::StaticOrder, true, true>(lds, g, S, E);
        {   CONV_SETUP(33 * 44); if (cdo) { prep_matrix(A.in[21], D, D, WGLU, 1, 0, cscr, cgw, cngw, lane); prep_matrix(A.in[22], D, D, WGLU, 1, 1, cscr, cgw, cngw, lane); } } }
    SEAM(6);
    PH(7) { pg8::Gemm g{ACT, WDN0, MP, D, FF};
#if SPLITK
        SplitOrder S; S.init(D, FF, SPLITK, G, bid); EpiRes<1, true, true> E{XRES, nullptr, nullptr, nullptr, SSQ2}; EpiMux<EpiRes<1, true, true>> EM{E, PART, D}; pg8::gemm_phase<EpiMux<EpiRes<1, true, true>>, SplitOrder, true, true>(lds, g, S, EM);
        grid.sync(); reduce_partials<SPLITK>(PART, D, G, bid); grid.sync(); finalize_sample(E, PART, D, 1, G, bid);
#else
        pg8::StaticOrder S; S.init(MP, D, G, bid, FF); EpiRes<1, false, false> E{XRES, nullptr, nullptr, nullptr, nullptr}; pg8::gemm_phase<EpiRes<1, false, false>, pg8::StaticOrder, true, true>(lds, g, S, E);
#endif
        }
    SEAM(7);
    PH(9) {
        for (int u = bid; u < 512 + 256; u += G) { if (u < 512) s5_prompt_unit(A, XRES, SSQ2, H, lds, u); else s5_sample_unit(A, XRES, SSQ2, H, lds, u - 512); }
    }
    SEAM(9);
    PH(10) { pg8::Gemm g{H, WGLU, MP, 2 * D, D}; pg8::StaticOrder S; S.init(MP, 2 * D, G, bid, D); EpiRes<2, false, true> E{XRES, nullptr, nullptr, XB, SSQ1}; pg8::gemm_phase<EpiRes<2, false, true>, pg8::StaticOrder, true, true>(lds, g, S, E);
        {   CONV_SETUP(33 * 16);
            if (cdo) { prep_matrix(A.in[24] + (size_t)D * FF, D, FF, WGU1, 1, 0, cscr, cgw, cngw, lane, A.in[23] + D);
                prep_matrix(A.in[25] + (size_t)D * FF, D, FF, WGU1, 1, 1, cscr, cgw, cngw, lane, A.in[23] + D); } } }
    SEAM(10);
    PH(12) { pg8::Gemm g{XB, WGU1, MP, 2 * FF, D}; pg8::StaticOrder S; S.init(MP, 2 * FF, G, bid, D); EpiGU E{ACT, SSQ1}; pg8::gemm_phase<EpiGU, pg8::StaticOrder, true, true>(lds, g, S, E);
        {   CONV_SETUP(33 * 44); if (cdo) prep_matrix(A.in[26] + (size_t)D * FF, FF, D, WDN1, 0, 0, cscr, cgw, cngw, lane); } }
    SEAM(12);
    PH(13) { pg8::Gemm g{ACT, WDN1, MP, D, FF};
#if SPLITK
        SplitOrder S; S.init(D, FF, SPLITK, G, bid); EpiRes<1, true, false> E{XRES, nullptr, nullptr, nullptr, nullptr}; EpiMux<EpiRes<1, true, false>> EM{E, PART, D}; pg8::gemm_phase<EpiMux<EpiRes<1, true, false>>, SplitOrder, true, true>(lds, g, S, EM);
        grid.sync(); reduce_partials<SPLITK>(PART, D, G, bid); grid.sync(); finalize_sample(E, PART, D, 1, G, bid);
#else
        pg8::StaticOrder S; S.init(MP, D, G, bid, FF); EpiRes<1, false, false> E{XRES, nullptr, nullptr, nullptr, nullptr}; pg8::gemm_phase<EpiRes<1, false, false>, pg8::StaticOrder, true, true>(lds, g, S, E);
#endif
        }
    SEAM(13);
    PH(14) rms_rows<true>(XRES, nullptr, A.in[27], A.out + O_Y, gw, NGW, lane);
#undef IN
#undef SEAM
}

extern "C" void kernel_launch(void* const* d_in, const int* in_sizes, int n_in, void* d_out, int out_size, void* d_ws, size_t ws_size, hipStream_t stream) {
    static int grid = 0;
    if (grid == 0) {
        if (n_in != 28 || (size_t)out_size != O_END || ws_size < WS_END) { fprintf(stderr, "kernel_launch: unexpected shapes n_in %d out %d ws %zu\n", n_in, out_size, ws_size); grid = -1; return; }
        int dev = 0, cus = 0, per_cu = 0;
        (void)hipGetDevice(&dev); (void)hipDeviceGetAttribute(&cus, hipDeviceAttributeMultiprocessorCount, dev);
        if (hipFuncSetAttribute((const void*)fwd_kernel, hipFuncAttributeMaxDynamicSharedMemorySize, LDS_BYTES) != hipSuccess) { fprintf(stderr, "kernel_launch: hipFuncSetAttribute failed\n"); grid = -1; return; }
        if (hipOccupancyMaxActiveBlocksPerMultiprocessor(&per_cu, (const void*)fwd_kernel, 512, LDS_BYTES) != hipSuccess || per_cu < 1) { fprintf(stderr, "kernel_launch: occupancy query says %d\n", per_cu); per_cu = 1; }
        (void)hipGetLastError();
        grid = cus;
        fprintf(stderr, "kernel_launch: grid %d (cus %d, per_cu %d)\n", grid, cus, per_cu);
    }
    if (grid < 0) return;
    Args a{};
    for (int i = 0; i < 28; ++i) a.in[i] = (const float*)d_in[i];
    a.out = (float*)d_out; a.ws = (unsigned char*)d_ws;
#if ONE_LAUNCH
    a.ph_lo = 0; a.ph_hi = NPH;
    void* args[] = {&a};
    hipError_t e = hipLaunchCooperativeKernel((const void*)fwd_kernel, dim3(grid), dim3(512), args, LDS_BYTES, stream);
    if (e != hipSuccess) fprintf(stderr, "kernel_launch: cooperative launch failed: %s\n", hipGetErrorString(e));
#else
    for (int ph = 0; ph < NPH; ++ph) { a.ph_lo = ph; a.ph_hi = ph + 1; hipLaunchKernelGGL(fwd_kernel, dim3(grid), dim3(512), LDS_BYTES, stream, a); }
#endif
}
```
